# Optimizing an MI355X kernel written in HIP

```python
import math
import jax, jax.numpy as jnp
from jax import lax
import numpy as np

D_MODEL = 1024
BATCH = 8
SEQ = 4096
DEPTH = 1
DEC_BATCH = 8
DEC_SEQ = 32
PAST_LEN = 1024

CHUNK = 64
N_META = 16
H_ATT = 4
D_QK = 64
D_V = 2 * D_QK
W_ATT = H_ATT * D_V
W_CONV = D_MODEL - W_ATT
CONV_W = 3
N_SPLIT = 8
W_IN = W_ATT * 4 + W_CONV * 4
N_BUCKETS = 32
MAX_DIST = 128
Q_BLOCK = 128
EPS = 1e-6
NEG = -1e30
SCALE = D_QK ** -0.5

kernel_name = "hybrid_diffattn_shortconv_stream_step"

f32 = jnp.float32


def rmsnorm(x, g):
    xf = x.astype(f32)
    y = xf * lax.rsqrt(jnp.mean(xf * xf, axis=-1, keepdims=True) + EPS)
    return (y * g.astype(f32)).astype(x.dtype)


def rel_bucket(rel):
    nb = N_BUCKETS // 2
    ret = jnp.where(rel > 0, nb, 0)
    n = jnp.abs(rel)
    max_exact = nb // 2
    nf = jnp.maximum(n, 1).astype(f32)
    large = max_exact + (jnp.log(nf / max_exact) / math.log(MAX_DIST / max_exact)
                         * (nb - max_exact)).astype(jnp.int32)
    large = jnp.minimum(large, nb - 1)
    return ret + jnp.where(n < max_exact, n, large)


def chunk_id(pos):
    return jnp.where(pos < 0, -1, pos // CHUNK)


def split_proj(n, w):
    p = n @ w
    b, l = p.shape[:2]
    q, k, v, z_a, b_g, c_g, u, z_c = jnp.split(p, N_SPLIT, axis=-1)
    q = q.reshape(b, l, H_ATT, 2, D_QK)
    k = k.reshape(b, l, H_ATT, 2, D_QK)
    v = v.reshape(b, l, H_ATT, D_V)
    return q, k, v, z_a, b_g, c_g, u, z_c


def diff_lambda(lq1, lk1, lq2, lk2, lam_init):
    return (jnp.exp(jnp.sum(lq1.astype(f32) * lk1.astype(f32)))
            - jnp.exp(jnp.sum(lq2.astype(f32) * lk2.astype(f32))) + lam_init)


def diff_attend(q, k, v, q_pos, k_pos, lam, rel_bias):
    s = jnp.einsum('bqhcd,bkhcd->bchqk', q, k, preferred_element_type=f32) * SCALE
    bias = rel_bias[rel_bucket(k_pos[None, :] - q_pos[:, None])]
    s = s + jnp.transpose(bias, (2, 0, 1)).astype(f32)[None, None]
    vis = chunk_id(k_pos)[None, :] <= chunk_id(q_pos)[:, None]
    s = jnp.where(vis, s, NEG)
    p = jax.nn.softmax(s, axis=-1)
    a = p[:, 0] - lam * p[:, 1]
    return jnp.einsum('bhqk,bkhd->bqhd', a.astype(v.dtype), v)


def short_conv(u_pad, w):
    l = u_pad.shape[1] - (CONV_W - 1)
    out = w[0] * u_pad[:, 0:l]
    for j in range(1, CONV_W):
        out = out + w[j] * u_pad[:, j:j + l]
    return out


def merge_branches(o, sub_g, lam_init, z_a, conv_out, b_g, z_c, w_o):
    o = rmsnorm(o, sub_g) * (1.0 - lam_init)
    o = o.reshape(*o.shape[:2], W_ATT) * jax.nn.silu(z_a)
    y_c = jax.nn.silu(z_c) * b_g * conv_out
    return jnp.concatenate([o, y_c], axis=-1) @ w_o


def setup_inputs(seed: int = 0) -> dict:
    key = jax.random.key(seed)
    ks = jax.random.split(key, 17)
    nrm = jax.random.normal
    return {
        "x_prompt": nrm(ks[0], (BATCH, SEQ, D_MODEL), f32),
        "x_sample": nrm(ks[1], (DEC_BATCH, DEC_SEQ, D_MODEL), f32),
        "cache_k": nrm(ks[2], (DEPTH, DEC_BATCH, N_META + PAST_LEN, H_ATT, 2 * D_QK), f32),
        "cache_v": nrm(ks[3], (DEPTH, DEC_BATCH, N_META + PAST_LEN, H_ATT, D_V), f32),
        "state_conv": nrm(ks[4], (DEPTH, DEC_BATCH, CONV_W - 1, W_CONV), f32),
        "meta_tokens": nrm(ks[5], (N_META, D_MODEL), f32),
        "rel_bias": 0.1 * nrm(ks[6], (N_BUCKETS, H_ATT), f32),
        "norm_g": 1.0 + 0.1 * nrm(ks[7], (DEPTH, D_MODEL), f32),
        "w_in": nrm(ks[8], (DEPTH, D_MODEL, W_IN), f32) * D_MODEL ** -0.5,
        "conv_w": nrm(ks[9], (DEPTH, CONV_W, W_CONV), f32) * CONV_W ** -0.5,
        "lambda_q1": 0.1 * nrm(ks[10], (DEPTH, D_QK), f32),
        "lambda_k1": 0.1 * nrm(ks[11], (DEPTH, D_QK), f32),
        "lambda_q2": 0.1 * nrm(ks[12], (DEPTH, D_QK), f32),
        "lambda_k2": 0.1 * nrm(ks[13], (DEPTH, D_QK), f32),
        "subln_g": 1.0 + 0.1 * nrm(ks[14], (DEPTH, D_V), f32),
        "w_out": nrm(ks[15], (DEPTH, W_ATT + W_CONV, D_MODEL), f32) * (W_ATT + W_CONV) ** -0.5,
        "final_g": 1.0 + 0.1 * nrm(ks[16], (D_MODEL,), f32),
    }


def reference(x_prompt, x_sample, cache_k, cache_v, state_conv, meta_tokens, rel_bias,
              norm_g, w_in, conv_w, lambda_q1, lambda_k1, lambda_q2, lambda_k2,
              subln_g, w_out, final_g):
    bp, sp = x_prompt.shape[:2]
    bd, sd = x_sample.shape[:2]
    past = cache_k.shape[2] - N_META
    n_blk = sp // Q_BLOCK

    meta_pos = jnp.arange(-N_META, 0, dtype=jnp.int32)
    p_qpos = jnp.arange(sp, dtype=jnp.int32)
    p_kpos = jnp.concatenate([meta_pos, p_qpos])
    d_qpos = past + jnp.arange(sd, dtype=jnp.int32)
    d_kpos = jnp.concatenate([meta_pos, jnp.arange(past, dtype=jnp.int32), d_qpos])

    hp = jnp.concatenate(
        [jnp.broadcast_to(meta_tokens[None].astype(x_prompt.dtype), (bp, N_META, D_MODEL)), x_prompt],
        axis=1)
    hd = x_sample

    kp_l, vp_l, cp_l, kd_l, vd_l, cd_l = [], [], [], [], [], []
    for l in range(DEPTH):
        lam_init = 0.8 - 0.6 * math.exp(-0.3 * l)
        lam = diff_lambda(lambda_q1[l], lambda_k1[l], lambda_q2[l], lambda_k2[l], lam_init)

        q, k, v, z_a, b_g, c_g, u, z_c = split_proj(rmsnorm(hp, norm_g[l]), w_in[l])
        o_meta = diff_attend(q[:, :N_META], k[:, :N_META], v[:, :N_META],
                             meta_pos, meta_pos, lam, rel_bias)
        q_blk = jnp.transpose(q[:, N_META:].reshape(bp, n_blk, Q_BLOCK, H_ATT, 2, D_QK),
                              (1, 0, 2, 3, 4, 5))
        pos_blk = p_qpos.reshape(n_blk, Q_BLOCK)
        o_frm = lax.map(lambda a: diff_attend(a[0], k, v, a[1], p_kpos, lam, rel_bias),
                        (q_blk, pos_blk))
        o_frm = jnp.transpose(o_frm, (1, 0, 2, 3, 4)).reshape(bp, sp, H_ATT, D_V)
        o = jnp.concatenate([o_meta, o_frm], axis=1)
        u_pad = jnp.concatenate([jnp.zeros((bp, CONV_W - 1, W_CONV), u.dtype), c_g * u], axis=1)
        hp = hp + merge_branches(o, subln_g[l], lam_init, z_a,
                                 short_conv(u_pad, conv_w[l]), b_g, z_c, w_out[l])
        kp_l.append(k.reshape(bp, N_META + sp, H_ATT, 2 * D_QK))
        vp_l.append(v)
        cp_l.append(u_pad[:, -(CONV_W - 1):])

        q2, k2, v2, z_a2, b_g2, c_g2, u2, z_c2 = split_proj(rmsnorm(hd, norm_g[l]), w_in[l])
        k_all = jnp.concatenate(
            [cache_k[l].reshape(bd, N_META + past, H_ATT, 2, D_QK).astype(k2.dtype), k2], axis=1)
        v_all = jnp.concatenate([cache_v[l].astype(v2.dtype), v2], axis=1)
        o2 = diff_attend(q2, k_all, v_all, d_qpos, d_kpos, lam, rel_bias)
        u2_pad = jnp.concatenate([state_conv[l].astype(u2.dtype), c_g2 * u2], axis=1)
        hd = hd + merge_branches(o2, subln_g[l], lam_init, z_a2,
                                 short_conv(u2_pad, conv_w[l]), b_g2, z_c2, w_out[l])
        kd_l.append(k2.reshape(bd, sd, H_ATT, 2 * D_QK))
        vd_l.append(v2)
        cd_l.append(u2_pad[:, -(CONV_W - 1):])

    y_prompt = rmsnorm(hp[:, N_META:], final_g)
    y_sample = rmsnorm(hd, final_g)
    return (y_prompt, y_sample, jnp.stack(kp_l), jnp.stack(vp_l), jnp.stack(cp_l),
            jnp.stack(kd_l), jnp.stack(vd_l), jnp.stack(cd_l))
```

```cpp
#include <hip/hip_runtime.h>
#include <hip/hip_cooperative_groups.h>
#include <cstdio>
#include <cstdint>
namespace cg = cooperative_groups;
namespace pg8 {
#define PG8_LAS __attribute__((address_space(3)))
typedef unsigned short bf16_t;
typedef short bf16x8 __attribute__((ext_vector_type(8)));
typedef float f32x4 __attribute__((ext_vector_type(4)));
typedef unsigned u32x4 __attribute__((ext_vector_type(4)));
constexpr int BM = 256, BK = 64, HALF = 128, HTB = HALF * BK * 2  , STAGE_BYTES = 8 * HTB, NXCD = 8, WGM = 8;

__host__ __device__ __forceinline__ int lds_byte(int r, int c) { const int st = (r >> 4) * 2 + (c >> 5), rr = r & 15, cc = c & 31, ob = rr * 64 + cc * 2; return st * 1024 + (ob ^ (((ob >> 9) & 1) << 5)); }
__host__ __device__ __forceinline__ void stage_rc(int b, int& R, int& C) { const int st = b / 1024, sb = b % 1024, swz = sb ^ (((sb >> 9) & 1) << 5); R = (st >> 1) * 16 + swz / 64; C = (st & 1) * 32 + (swz % 64) / 2; }
__host__ __device__ __forceinline__ int perm32(int rho) { const int n = rho >> 4, i = rho & 15; return 8 * (i >> 2) + 4 * n + (i & 3); }

struct Unit { int pm, pn; };
struct Gemm { const bf16_t* A; const bf16_t* Bt; int M, N, K; };

struct StaticOrder {
    int nM, nN, nwg, G, c;
    __host__ __device__ void init(int M, int N, int G_, int c_) { nM = M / BM; nN = N / BM; nwg = nM * nN; G = G_; c = c_; }
    __host__ __device__ bool next(int i, Unit& u) const {
        const long L = (long)i * G + c; if (L >= nwg) return false;
        int wgid = (int)L; { const int q = nwg / NXCD, r = nwg % NXCD, xcd = wgid % NXCD, off = wgid / NXCD; wgid = (xcd < r ? xcd * (q + 1) : r * (q + 1) + (xcd - r) * q) + off; }
        const int nig = WGM * nN, gid = wgid / nig, fm = gid * WGM, gsz = (nM - fm) < WGM ? (nM - fm) : WGM;
        u.pm = fm + ((wgid % nig) % gsz); u.pn = (wgid % nig) / gsz; return true;
    }
    __device__ __forceinline__ void a_ready(const Unit&) const {}
    __device__ __forceinline__ void done(const Unit&) const {}
};
template <class Epi, class Sched, bool ALIGN_EPI = false, bool SP2 = false>
__device__ __forceinline__ void gemm_phase(PG8_LAS unsigned char* lds, const Gemm g, const Sched& S, const Epi& E) {
    const int tid = threadIdx.x, wid = __builtin_amdgcn_readfirstlane(tid >> 6), lane = tid & 63, wr = wid >> 2, wc = wid & 3, fr = lane & 15, fq = lane >> 4;
    const int K = g.K, nt = K / BK;
    unsigned voffA[2], voffB[2];
#pragma unroll
    for (int i = 0; i < 2; ++i) { int R, C; stage_rc(tid * 16 + i * 8192, R, C); const int Rb = Epi::PERM ? ((R & ~31) + perm32(R & 31)) : R;
        voffA[i] = (unsigned)(R * K + C) * 2u; voffB[i] = (unsigned)(Rb * K + C) * 2u; }
    const size_t kstep = (size_t)(BK * 2);
    const size_t hstep = (size_t)HALF * K * 2;
    const size_t tstep = 2 * hstep;
    const unsigned ldsw = (unsigned)wid * 1024u;
    const int aoff = lds_byte(wr * 64 + fr, fq * 8), boff = lds_byte(wc * 32 + fr, fq * 8);
#define PG8_SA(b, h) (((b) * 2 + (h)) * HTB)
#define PG8_SB(b, h) ((4 + (b) * 2 + (h)) * HTB)
#define PG8_STAGE(bufoff, gbase, voff) do { _Pragma("unroll") for (int _i = 0; _i < 2; ++_i) \
        __builtin_amdgcn_global_load_lds((const unsigned*)((const char*)(gbase) + (voff)[_i]), (PG8_LAS unsigned*)(lds + (bufoff) + ldsw + _i * 8192), 16, 0, 0); } while (0)
#define PG8_LDA(dst, b, h) do { _Pragma("unroll") for (int m = 0; m < 4; ++m) _Pragma("unroll") for (int k = 0; k < 2; ++k) dst[m][k] = *(const PG8_LAS bf16x8*)(lds + PG8_SA(b, h) + aoff + m * 2048 + k * 1024); } while (0)
#define PG8_LDB(dst, b, h) do { _Pragma("unroll") for (int n = 0; n < 2; ++n) _Pragma("unroll") for (int k = 0; k < 2; ++k) dst[n][k] = *(const PG8_LAS bf16x8*)(lds + PG8_SB(b, h) + boff + n * 2048 + k * 1024); } while (0)
#define PG8_MMA(ai, bj, At, Bt) do { __builtin_amdgcn_s_setprio(1); _Pragma("unroll") for (int m = 0; m < 4; ++m) _Pragma("unroll") for (int n = 0; n < 2; ++n) _Pragma("unroll") for (int k = 0; k < 2; ++k) \
        acc[ai][bj][m][n] = __builtin_amdgcn_mfma_f32_16x16x32_bf16(Bt[n][k], At[m][k], acc[ai][bj][m][n], 0, 0, 0); __builtin_amdgcn_s_setprio(0); } while (0)
#define PG8_WAIT_V(n) asm volatile("s_waitcnt vmcnt(" #n ")" ::: "memory")
#define PG8_WAIT_L(n) asm volatile("s_waitcnt lgkmcnt(" #n ")" ::: "memory")
#define PG8_BAR __builtin_amdgcn_s_barrier()
#define PG8_SCHED __builtin_amdgcn_sched_barrier(0)
    Unit cur, nxt; int ui = 0;
    if (!S.next(0, cur)) return;
    f32x4 acc[2][2][4][2];
#pragma unroll
    for (int a = 0; a < 2; ++a)
#pragma unroll
        for (int b = 0; b < 2; ++b)
#pragma unroll
            for (int m = 0; m < 4; ++m)
#pragma unroll
                for (int n = 0; n < 2; ++n) acc[a][b][m][n] = (f32x4){0.f, 0.f, 0.f, 0.f};
    bf16x8 At[4][2], B0[2][2], B1[2][2];
    const char* cA = (const char*)g.A + (size_t)cur.pm * tstep; const char* cB = (const char*)g.Bt + (size_t)cur.pn * tstep;
    S.a_ready(cur);
    if constexpr (SP2) {
        PG8_STAGE(PG8_SB(0, 0), cB, voffB); PG8_STAGE(PG8_SB(0, 1), cB + hstep, voffB); PG8_STAGE(PG8_SA(0, 0), cA, voffA); PG8_STAGE(PG8_SA(0, 1), cA + hstep, voffA);
        if (wr == 1) PG8_BAR;
        PG8_WAIT_V(2); PG8_BAR;
        PG8_STAGE(PG8_SB(1, 0), cB + kstep, voffB); PG8_STAGE(PG8_SA(1, 0), cA + kstep, voffA); PG8_STAGE(PG8_SB(1, 1), cB + hstep + kstep, voffB);
        PG8_WAIT_V(6); PG8_BAR;
    } else {
        PG8_STAGE(PG8_SB(0, 0), cB, voffB); PG8_STAGE(PG8_SA(0, 0), cA, voffA); PG8_STAGE(PG8_SB(0, 1), cB + hstep, voffB); PG8_STAGE(PG8_SA(0, 1), cA + hstep, voffA);
        if (wr == 1) PG8_BAR;
        PG8_WAIT_V(4); PG8_BAR;
        PG8_STAGE(PG8_SB(1, 0), cB + kstep, voffB); PG8_STAGE(PG8_SA(1, 0), cA + kstep, voffA); PG8_STAGE(PG8_SB(1, 1), cB + hstep + kstep, voffB);
        PG8_WAIT_V(6); PG8_BAR;
    }
    for (;;) {
        const bool has_next = S.next(ui + 1, nxt);
        const char* nA = has_next ? (const char*)g.A + (size_t)nxt.pm * tstep : cA; const char* nB = has_next ? (const char*)g.Bt + (size_t)nxt.pn * tstep : cB;
        for (int t = 0; t < nt; t += 2) {
            const bool last = (t == nt - 2);
            const char* a1 = cA + (size_t)(t + 1) * kstep;
            const char* a2 = last ? nA : cA + (size_t)(t + 2) * kstep; const char* b2 = last ? nB : cB + (size_t)(t + 2) * kstep;
            const char* a3 = a2 + kstep; const char* b3 = b2 + kstep;
            if (last && has_next) S.a_ready(nxt);
            if constexpr (SP2) {
            PG8_LDB(B0, 0, 0); PG8_LDB(B1, 0, 1); PG8_SCHED; PG8_LDA(At, 0, 0); PG8_STAGE(PG8_SA(1, 1), a1 + hstep, voffA);
            PG8_WAIT_V(8); PG8_WAIT_L(0); PG8_BAR; PG8_MMA(0, 0, At, B0); PG8_MMA(0, 1, At, B1); PG8_BAR; PG8_SCHED;
            PG8_LDA(At, 0, 1); PG8_STAGE(PG8_SB(0, 0), b2, voffB); PG8_STAGE(PG8_SB(0, 1), b2 + hstep, voffB); PG8_STAGE(PG8_SA(0, 0), a2, voffA);
            PG8_WAIT_V(8); PG8_WAIT_L(0); PG8_BAR; PG8_MMA(1, 0, At, B0); PG8_MMA(1, 1, At, B1); PG8_BAR; PG8_SCHED;
            PG8_LDB(B0, 1, 0); PG8_LDB(B1, 1, 1); PG8_SCHED; PG8_LDA(At, 1, 0); PG8_STAGE(PG8_SA(0, 1), a2 + hstep, voffA);
            PG8_WAIT_V(8); PG8_WAIT_L(0); PG8_BAR; PG8_MMA(0, 0, At, B0); PG8_MMA(0, 1, At, B1); PG8_BAR; PG8_SCHED;
            PG8_LDA(At, 1, 1); PG8_STAGE(PG8_SB(1, 0), b3, voffB); PG8_STAGE(PG8_SB(1, 1), b3 + hstep, voffB); PG8_STAGE(PG8_SA(1, 0), a3, voffA);
            PG8_WAIT_V(8); PG8_WAIT_L(0); PG8_BAR; PG8_MMA(1, 0, At, B0); PG8_MMA(1, 1, At, B1); PG8_BAR; PG8_SCHED;
            } else {
            PG8_LDB(B0, 0, 0); PG8_SCHED; PG8_LDA(At, 0, 0); PG8_STAGE(PG8_SA(1, 1), a1 + hstep, voffA);
            PG8_WAIT_L(8); PG8_BAR; PG8_WAIT_L(0); PG8_MMA(0, 0, At, B0); PG8_BAR; PG8_SCHED;
            PG8_LDB(B1, 0, 1); PG8_STAGE(PG8_SB(0, 0), b2, voffB);
            PG8_BAR; PG8_WAIT_L(0); PG8_MMA(0, 1, At, B1); PG8_BAR;
            PG8_LDA(At, 0, 1); PG8_STAGE(PG8_SA(0, 0), a2, voffA);
            PG8_BAR; PG8_WAIT_L(0); PG8_MMA(1, 0, At, B0); PG8_BAR; PG8_SCHED;
            PG8_STAGE(PG8_SB(0, 1), b2 + hstep, voffB);
            PG8_WAIT_V(6); PG8_BAR; PG8_MMA(1, 1, At, B1); PG8_BAR;
            PG8_LDB(B0, 1, 0); PG8_SCHED; PG8_LDA(At, 1, 0); PG8_STAGE(PG8_SA(0, 1), a2 + hstep, voffA);
            PG8_WAIT_L(8); PG8_BAR; PG8_WAIT_L(0); PG8_MMA(0, 0, At, B0); PG8_BAR; PG8_SCHED;
            PG8_LDB(B1, 1, 1); PG8_STAGE(PG8_SB(1, 0), b3, voffB);
            PG8_BAR; PG8_WAIT_L(0); PG8_MMA(0, 1, At, B1); PG8_BAR;
            PG8_LDA(At, 1, 1); PG8_STAGE(PG8_SA(1, 0), a3, voffA);
            PG8_BAR; PG8_WAIT_L(0); PG8_MMA(1, 0, At, B0); PG8_BAR; PG8_SCHED;
            PG8_STAGE(PG8_SB(1, 1), b3 + hstep, voffB);
            PG8_WAIT_V(6); PG8_BAR; PG8_MMA(1, 1, At, B1); PG8_BAR;
            }
        }
        if constexpr (ALIGN_EPI) { if (wr == 0) PG8_BAR; }
        if constexpr (!Epi::AFTER_DRAIN) { E(acc, cur, wr, wc, fr, fq); S.done(cur); }
        if (!has_next) break;
#pragma unroll
        for (int a = 0; a < 2; ++a)
#pragma unroll
            for (int b = 0; b < 2; ++b)
#pragma unroll
                for (int m = 0; m < 4; ++m)
#pragma unroll
                    for (int n = 0; n < 2; ++n) acc[a][b][m][n] = (f32x4){0.f, 0.f, 0.f, 0.f};
        cur = nxt; cA = nA; cB = nB; ++ui;
        if constexpr (ALIGN_EPI) { if (wr == 1) PG8_BAR; }
    }
    PG8_WAIT_V(0);
    if constexpr (!ALIGN_EPI) { if (wr == 0) PG8_BAR; }
    PG8_BAR;
    if constexpr (Epi::AFTER_DRAIN) { E.fused(acc, cur, wr, wc, fr, fq, lds, wid, lane); S.done(cur); }
#undef PG8_SA
#undef PG8_SB
#undef PG8_STAGE
#undef PG8_LDA
#undef PG8_LDB
#undef PG8_MMA
#undef PG8_WAIT_V
#undef PG8_WAIT_L
#undef PG8_BAR
#undef PG8_SCHED
}
}

#ifndef N_LAUNCHES
#define N_LAUNCHES 1
#endif
constexpr int D = 1024, NB = 8, SEQ = 4096, DB = 8, DS = 32, PAST = 1024, NMETA = 16, NH = 4;
constexpr int MFR = NB * SEQ;
constexpr int MDR = DB * DS;
constexpr int R_DEC = MFR, R_META = MFR + MDR, R_ALL = R_META + NMETA;
constexpr int KVP = NMETA + SEQ;
constexpr int KVD = NMETA + PAST + DS;
constexpr int WIN = 4096;
constexpr float EPS = 1e-6f;
constexpr float LOG2E = 1.4426950408889634f;
constexpr float QSCALE = 0.125f * LOG2E;
constexpr float LAM_INIT = 0.2f;
constexpr size_t O_YP = 0, O_YS = 33554432, O_KP = 33816576, O_VP = 50659328, O_CP = 67502080, O_KS = 67510272, O_VS = 67641344, O_CS = 67772416, O_END = 67780608;
constexpr size_t MiB = 1u << 20;
constexpr size_t WS_PART = 1 * MiB;
constexpr size_t WS_PARTD = 3 * MiB;
constexpr size_t WS_WIN = 4 * MiB;
constexpr size_t WS_WOUT = 12 * MiB;
constexpr size_t WS_XN = 16 * MiB;
constexpr size_t WS_Q = 96 * MiB;
constexpr size_t WS_ZA = 132 * MiB;
constexpr size_t WS_G = 168 * MiB;
constexpr size_t WS_K = 204 * MiB;
constexpr size_t WS_V = 240 * MiB;
constexpr size_t WS_CU = 276 * MiB;
constexpr size_t WS_KD = 312 * MiB;
constexpr size_t WS_VD = 324 * MiB;
constexpr size_t WS_CUD = 336 * MiB;
constexpr size_t WS_M = 340 * MiB;
constexpr size_t WS_END = 408 * MiB;

constexpr int LDS_BYTES = 147456;
constexpr int NWAVES = 8;

#define LAS __attribute__((address_space(3)))
typedef unsigned short bf16;
typedef unsigned u32x4 __attribute__((ext_vector_type(4)));
typedef unsigned u32x2 __attribute__((ext_vector_type(2)));
typedef float f32x4 __attribute__((ext_vector_type(4)));
typedef float f32x2 __attribute__((ext_vector_type(2)));
typedef float f32x16 __attribute__((ext_vector_type(16)));
typedef short bf16x8 __attribute__((ext_vector_type(8)));
typedef short s16x4 __attribute__((ext_vector_type(4)));
typedef __bf16 bf16x2_t __attribute__((ext_vector_type(2)));

__device__ __forceinline__ unsigned pk2(float lo, float hi) { f32x2 v = {lo, hi}; bf16x2_t b = __builtin_convertvector(v, bf16x2_t); return __builtin_bit_cast(unsigned, b); }
__device__ __forceinline__ bf16 f2bf(float f) { return (bf16)(pk2(f, 0.f) & 0xffffu); }
__device__ __forceinline__ float bf2f(unsigned short b) { return __builtin_bit_cast(float, ((unsigned)b) << 16); }
__device__ __forceinline__ float bflo(unsigned w) { return __builtin_bit_cast(float, w << 16); }
__device__ __forceinline__ float bfhi(unsigned w) { return __builtin_bit_cast(float, w & 0xffff0000u); }
__device__ __forceinline__ float ex2(float x) { return __builtin_amdgcn_exp2f(x); }
__device__ __forceinline__ float silu(float x) { return x * __builtin_amdgcn_rcpf(1.0f + ex2(-x * LOG2E)); }
__device__ __forceinline__ float wave_sum(float v) {
#pragma unroll
    for (int o = 1; o < 64; o <<= 1) v += __shfl_xor(v, o);
    return v;
}
__device__ __forceinline__ float swap32f(float v) { return __shfl_xor(v, 32); }
#define LDS_WAIT() asm volatile("s_waitcnt lgkmcnt(0)" ::: "memory")

struct Ptrs {
    const float *xp, *xs, *ck, *cv, *sc, *meta, *relb, *ng, *win, *cw, *lq1, *lk1, *lq2, *lk2, *sg, *wout, *fg;
    float* out;
    bf16 *WtIn, *WtOut, *XN, *Qb, *ZA, *Gb, *Kb, *Vb, *CUb, *KbD, *VbD, *CUd, *Mb;
    float *part, *partD;
};

__device__ __forceinline__ int win_src_col(int n) {
    if (n < 2048) return n;
    if (n < 3072) { const int u = (n - 2048) >> 8, w = (n - 2048) & 255; return w < 128 ? 2048 + 128 * u + w : 3584 + 128 * u + (w - 128); }
    const int u = (n - 3072) >> 8, w = (n - 3072) & 255; return w < 128 ? 2560 + 128 * u + w : 3072 + 128 * u + (w - 128);
}
__device__ __forceinline__ void p0_transpose_item(const float* W, int N, int K, bf16* WT, int n_src0, int n_dst0, int k0, LAS float* scr, int lane) {
#pragma unroll 8
    for (int i = 0; i < 32; ++i) { const int kk = 2 * i + (lane >> 5); scr[kk * 33 + (lane & 31)] = W[(size_t)(k0 + kk) * N + n_src0 + (lane & 31)]; }
    LDS_WAIT(); asm volatile("" ::: "memory");
    const int c = lane & 7;
#pragma unroll
    for (int j = 0; j < 4; ++j) { const int n = (lane >> 3) + 8 * j; const LAS float* s = scr + (8 * c) * 33 + n;
        u32x4 o; o.x = pk2(s[0 * 33], s[1 * 33]); o.y = pk2(s[2 * 33], s[3 * 33]); o.z = pk2(s[4 * 33], s[5 * 33]); o.w = pk2(s[6 * 33], s[7 * 33]);
        *(u32x4*)(WT + (size_t)(n_dst0 + n) * K + k0 + 8 * c) = o; }
    LDS_WAIT(); asm volatile("" ::: "memory");
}
__device__ __forceinline__ void rms_row_to_bf16(const float* xrow, const float* g, bf16* orow, int lane) {
    const f32x4* xr = (const f32x4*)xrow + lane; const f32x4* gr = (const f32x4*)g + lane;
    f32x4 v[4]; float s = 0.f;
#pragma unroll
    for (int j = 0; j < 4; ++j) { v[j] = xr[64 * j]; s += (v[j].x * v[j].x + v[j].y * v[j].y) + (v[j].z * v[j].z + v[j].w * v[j].w); }
    const float rstd = 1.0f / sqrtf(wave_sum(s) * (1.f / D) + EPS);
    u32x2* o8 = (u32x2*)orow + lane;
#pragma unroll
    for (int j = 0; j < 4; ++j) { const f32x4 gg = gr[64 * j]; u32x2 o; o.x = pk2(v[j].x * rstd * gg.x, v[j].y * rstd * gg.y); o.y = pk2(v[j].z * rstd * gg.z, v[j].w * rstd * gg.w); o8[64 * j] = o; }
}
__device__ __forceinline__ void p0_prologue(const Ptrs& P, LAS unsigned char* lds, int vcu, int G, int wave, int lane) {
    LAS float* scr = (LAS float*)(lds + wave * 16384);
    const int gw = vcu * NWAVES + wave, NGW = G * NWAVES;
    constexpr int I_IN = (D / 64) * (WIN / 32), I_OUT = (D / 64) * (D / 32);
    for (int it = gw; it < I_IN + I_OUT; it += NGW) {
        if (it < I_IN) { const int kb = it / (WIN / 32), nb = it % (WIN / 32); p0_transpose_item(P.win, WIN, D, P.WtIn, win_src_col(32 * nb), 32 * nb, 64 * kb, scr, lane); }
        else { const int r = it - I_IN, kb = r / (D / 32), nb = r % (D / 32); p0_transpose_item(P.wout, D, D, P.WtOut, 32 * nb, 32 * nb, 64 * kb, scr, lane); }
    }
    for (int R = gw; R < R_ALL; R += NGW) {
        const float* xr = R < R_DEC ? P.xp + (size_t)R * D : (R < R_META ? P.xs + (size_t)(R - R_DEC) * D : P.meta + (size_t)(R - R_META) * D);
        rms_row_to_bf16(xr, P.ng, P.XN + (size_t)R * D, lane);
    }
    constexpr int CROWS = DB * (NMETA + PAST);
    for (int it = gw; it < 2 * CROWS; it += NGW) {
        const int isv = it >= CROWS, r = isv ? it - CROWS : it, b = r / (NMETA + PAST), j = r % (NMETA + PAST);
        const float* src = (isv ? P.cv : P.ck) + (size_t)r * 512 + lane * 8;
        bf16* dst = (isv ? P.VbD : P.KbD) + ((size_t)b * KVD + j) * 512 + lane * 8;
        const f32x4 a = *(const f32x4*)src, c = *(const f32x4*)(src + 4);
        u32x4 o; o.x = pk2(a.x, a.y); o.y = pk2(a.z, a.w); o.z = pk2(c.x, c.y); o.w = pk2(c.z, c.w);
        *(u32x4*)dst = o;
    }
}

__device__ __forceinline__ u32x4 pack8(const f32x4 a, const f32x4 b) { u32x4 w; w.x = pk2(a.x, a.y); w.y = pk2(a.z, a.w); w.z = pk2(b.x, b.y); w.w = pk2(b.z, b.w); return w; }
__device__ __forceinline__ f32x4 silu4(const f32x4 a) { return (f32x4){silu(a.x), silu(a.y), silu(a.z), silu(a.w)}; }
struct EpiIn {
    static constexpr bool PERM = true, AFTER_DRAIN = false;
    bf16 *Qb, *ZA, *Gb, *Kb, *Vb, *CUb; float* out;
    __device__ __forceinline__ void operator()(const f32x4 (&acc)[2][2][4][2], const pg8::Unit& u, int wr, int wc, int fr, int fq) const {
        const int typ = u.pn >> 1;
        const int b = u.pm >> 4, t0 = (u.pm & 15) * 256 + wr * 64 + fr;
        const size_t rowA0 = (size_t)u.pm * 256 + wr * 64 + fr, kvrow0 = (size_t)b * KVP + NMETA + t0;
        if (typ == 0) {
            const int col = (u.pn & 1) * 256 + wc * 32 + 8 * fq;
#pragma unroll
            for (int ai = 0; ai < 2; ++ai)
#pragma unroll
                for (int m = 0; m < 4; ++m) { bf16* rp = Qb + (rowA0 + ai * 128 + m * 16) * 512 + col;
#pragma unroll
                    for (int bj = 0; bj < 2; ++bj) *(u32x4*)(rp + bj * 128) = pack8(acc[ai][bj][m][0] * QSCALE, acc[ai][bj][m][1] * QSCALE); }
        } else if (typ == 1 || typ == 2) {
            const int col = (u.pn & 1) * 256 + wc * 32 + 8 * fq;
            float* o = out + (typ == 1 ? O_KP : O_VP); bf16* kb = typ == 1 ? Kb : Vb;
#pragma unroll
            for (int ai = 0; ai < 2; ++ai)
#pragma unroll
                for (int m = 0; m < 4; ++m) { const size_t off = (kvrow0 + ai * 128 + m * 16) * 512 + col;
#pragma unroll
                    for (int bj = 0; bj < 2; ++bj) { *(f32x4*)(o + off + bj * 128) = acc[ai][bj][m][0]; *(f32x4*)(o + off + bj * 128 + 4) = acc[ai][bj][m][1];
                        *(u32x4*)(kb + off + bj * 128) = pack8(acc[ai][bj][m][0], acc[ai][bj][m][1]); } }
        } else if (typ == 3) {
            const int col = (u.pn & 1) * 256 + wc * 32 + 8 * fq;
#pragma unroll
            for (int ai = 0; ai < 2; ++ai)
#pragma unroll
                for (int m = 0; m < 4; ++m) { bf16* rp = ZA + (rowA0 + ai * 128 + m * 16) * 512 + col;
#pragma unroll
                    for (int bj = 0; bj < 2; ++bj) *(u32x4*)(rp + bj * 128) = pack8(silu4(acc[ai][bj][m][0]), silu4(acc[ai][bj][m][1])); }
        } else if (typ < 6) {
            const int col = (u.pn - 8) * 128 + wc * 32 + 8 * fq;
#pragma unroll
            for (int ai = 0; ai < 2; ++ai)
#pragma unroll
                for (int m = 0; m < 4; ++m)
                    *(u32x4*)(Gb + (rowA0 + ai * 128 + m * 16) * 512 + col) = pack8(silu4(acc[ai][1][m][0]) * acc[ai][0][m][0], silu4(acc[ai][1][m][1]) * acc[ai][0][m][1]);
        } else {
            const int col = (u.pn - 12) * 128 + wc * 32 + 8 * fq;
#pragma unroll
            for (int ai = 0; ai < 2; ++ai)
#pragma unroll
                for (int m = 0; m < 4; ++m) { const f32x4 c0 = acc[ai][0][m][0] * acc[ai][1][m][0], c1 = acc[ai][0][m][1] * acc[ai][1][m][1];
                    *(u32x4*)(CUb + (kvrow0 + ai * 128 + m * 16) * 512 + col) = pack8(c0, c1);
                    const int t = t0 + ai * 128 + m * 16;
                    if (t >= SEQ - 2) { float* cp = out + O_CP + ((size_t)b * 2 + (t - (SEQ - 2))) * 512 + col; *(f32x4*)cp = c0; *(f32x4*)(cp + 4) = c1; } }
        }
    }
};
struct EpiOut {
    static constexpr bool PERM = true, AFTER_DRAIN = false;
    const float* x; float* y; float* part;
    __device__ __forceinline__ void operator()(const f32x4 (&acc)[2][2][4][2], const pg8::Unit& u, int wr, int wc, int fr, int fq) const {
        const size_t row0 = (size_t)u.pm * 256 + wr * 64 + fr; const int col = u.pn * 256 + wc * 32 + 8 * fq;
#pragma unroll
        for (int ai = 0; ai < 2; ++ai)
#pragma unroll
            for (int m = 0; m < 4; ++m) { const size_t row = row0 + ai * 128 + m * 16, off = row * D + col; float ss = 0.f;
#pragma unroll
                for (int bj = 0; bj < 2; ++bj) {
                    const f32x4 h0 = *(const f32x4*)(x + off + bj * 128) + acc[ai][bj][m][0], h1 = *(const f32x4*)(x + off + bj * 128 + 4) + acc[ai][bj][m][1];
                    *(f32x4*)(y + off + bj * 128) = h0; *(f32x4*)(y + off + bj * 128 + 4) = h1;
                    ss += (h0.x * h0.x + h0.y * h0.y) + (h0.z * h0.z + h0.w * h0.w) + (h1.x * h1.x + h1.y * h1.y) + (h1.z * h1.z + h1.w * h1.w); }
                ss += __shfl_xor(ss, 16); ss += __shfl_xor(ss, 32);
                if (fq == 0) part[row * 16 + u.pn * 4 + wc] = ss; }
    }
};

template <int MFN>
__device__ __forceinline__ void small_mma_stage(const bf16* A, const bf16* Bt, int brow, LAS unsigned char* lds, int wave, int lane) {
    const int col = lane & 15, kq = lane >> 4;
    const bf16* bp = Bt + (size_t)brow * D + 128 * wave + 8 * kq;
    bf16x8 bfrag[4];
#pragma unroll
    for (int ks = 0; ks < 4; ++ks) bfrag[ks] = *(const bf16x8*)(bp + 32 * ks);
    __syncthreads();
    const bf16* ap = A + (size_t)col * D + 128 * wave + 8 * kq;
#pragma unroll 2
    for (int mf = 0; mf < MFN; ++mf) {
        f32x4 acc = (f32x4){0.f, 0.f, 0.f, 0.f};
#pragma unroll
        for (int ks = 0; ks < 4; ++ks) acc = __builtin_amdgcn_mfma_f32_16x16x32_bf16(*(const bf16x8*)(ap + (size_t)mf * 16 * D + 32 * ks), bfrag[ks], acc, 0, 0, 0);
        *(LAS f32x4*)(lds + ((wave * MFN + mf) * 64 + lane) * 16) = acc;
    }
    __syncthreads();
}
template <int MFN>
__device__ __forceinline__ f32x4 small_reduce(LAS unsigned char* lds, int mf, int lane) {
    f32x4 s = (f32x4){0.f, 0.f, 0.f, 0.f};
#pragma unroll
    for (int w = 0; w < 8; ++w) s += *(const LAS f32x4*)(lds + ((w * MFN + mf) * 64 + lane) * 16);
    return s;
}
__device__ __forceinline__ void small_in_tile(const Ptrs& P, LAS unsigned char* lds, int j, int wave, int lane) {
    const int col = lane & 15;
    int np;
    if (j < 128) np = 16 * j + col; else { const int jj = j - 128; np = 2048 + 256 * (jj >> 4) + 8 * (jj & 15) + (col & 7) + 128 * (col >> 3); }
    small_mma_stage<17>(P.XN + (size_t)R_DEC * D, P.WtIn, np, lds, wave, lane);
#pragma unroll 1
    for (int mf = wave; mf < 17; mf += 8) {
        const f32x4 res = small_reduce<17>(lds, mf, lane);
#pragma unroll
        for (int i = 0; i < 4; ++i) {
            const float v = res[i]; const float other = __shfl_xor(v, 8);
            const int rr = 16 * mf + 4 * (lane >> 4) + i;
            if (mf < 16) {
                const int b = rr >> 5, t = rr & 31; const size_t R = (size_t)R_DEC + rr;
                if (j < 128) { const int typ = np >> 9, cc = np & 511;
                    if (typ == 0) P.Qb[R * 512 + cc] = f2bf(v * QSCALE);
                    else if (typ == 1) { P.out[O_KS + (size_t)rr * 512 + cc] = v; P.KbD[((size_t)b * KVD + NMETA + PAST + t) * 512 + cc] = f2bf(v); }
                    else if (typ == 2) { P.out[O_VS + (size_t)rr * 512 + cc] = v; P.VbD[((size_t)b * KVD + NMETA + PAST + t) * 512 + cc] = f2bf(v); }
                    else P.ZA[R * 512 + cc] = f2bf(silu(v));
                } else if (col < 8) { const int jq = j - 128, u8 = jq >> 4, c = 128 * (u8 & 3) + 8 * (jq & 15) + col;
                    if (u8 < 4) P.Gb[R * 512 + c] = f2bf(silu(other) * v);
                    else { const float cu = v * other; P.CUd[(size_t)rr * 512 + c] = f2bf(cu); if (t >= DS - 2) P.out[O_CS + ((size_t)b * 2 + (t - (DS - 2))) * 512 + c] = cu; }
                }
            } else {
                const int m = rr - 256;
                if (j < 128) { const int typ = np >> 9, cc = np & 511;
                    if (typ == 1 || typ == 2) { float* o = P.out + (typ == 1 ? O_KP : O_VP); bf16* kb = typ == 1 ? P.Kb : P.Vb; const bf16 vb = f2bf(v);
                        for (int b = 0; b < NB; ++b) { const size_t off = ((size_t)b * KVP + m) * 512 + cc; o[off] = v; kb[off] = vb; } }
                } else if (col < 8) { const int jq = j - 128, u8 = jq >> 4, c = 128 * (u8 & 3) + 8 * (jq & 15) + col;
                    if (u8 >= 4) { const bf16 cb = f2bf(v * other); for (int b = 0; b < NB; ++b) P.CUb[((size_t)b * KVP + m) * 512 + c] = cb; } }
            }
        }
    }
}
__device__ __forceinline__ void small_out_tile(const Ptrs& P, LAS unsigned char* lds, int j, int wave, int lane) {
    const int rg = j >> 6, cg_ = j & 63, col = lane & 15, n = 16 * cg_ + col;
    small_mma_stage<4>(P.Mb + (size_t)(R_DEC + 64 * rg) * D, P.WtOut, n, lds, wave, lane);
    if (wave < 4) {
        const f32x4 res = small_reduce<4>(lds, wave, lane);
#pragma unroll
        for (int i = 0; i < 4; ++i) { const int r = 64 * rg + 16 * wave + 4 * (lane >> 4) + i;
            const float h = P.xs[(size_t)r * D + n] + res[i]; P.out[O_YS + (size_t)r * D + n] = h;
            float ss = h * h; ss += __shfl_xor(ss, 1); ss += __shfl_xor(ss, 2); ss += __shfl_xor(ss, 4); ss += __shfl_xor(ss, 8);
            if (col == 0) P.partD[r * 64 + cg_] = ss; }
    }
}

constexpr int AT_BUF = 32768, AT_V = 16384, AT_LUT = 65536, AT_XCH = 73728;
__device__ __forceinline__ int crow(int r, int hi) { return (r & 3) + 8 * (r >> 2) + 4 * hi; }
__device__ __forceinline__ int rel_bucket(int rel) {
    const int n = rel < 0 ? -rel : rel; int v;
    if (n < 8) v = n; else if (n < 12) v = 8; else if (n < 16) v = 9; else if (n < 23) v = 10; else if (n < 32) v = 11; else if (n < 46) v = 12; else if (n < 64) v = 13; else if (n < 91) v = 14; else v = 15;
    return (rel > 0 ? 16 : 0) + v;
}
__device__ __forceinline__ s16x4 vtr(const LAS unsigned char* p) { return __builtin_bit_cast(s16x4, __builtin_amdgcn_ds_read_tr16_b64_v4i16((LAS s16x4*)p)); }

__device__ __forceinline__ void attn_unit(const bool DEC, const Ptrs& P, LAS unsigned char* lds, int b, int h, int qb, float lam, int wave, int lane) {
    const int tid = threadIdx.x, g = wave >> 1, c = wave & 1, r32 = lane & 31, hi = lane >> 5;
    const int qpos0 = DEC ? PAST : 128 * qb + 32 * g;
    const size_t R0 = DEC ? (size_t)R_DEC + b * DS : (size_t)b * SEQ + qpos0;
    const bool active = DEC ? (g == 0) : true;
    const bf16* Kg = (DEC ? P.KbD + (size_t)b * KVD * 512 : P.Kb + (size_t)b * KVP * 512) + h * 128;
    const bf16* Vg = (DEC ? P.VbD + (size_t)b * KVD * 512 : P.Vb + (size_t)b * KVP * 512) + h * 128;
    const int NT = DEC ? 18 : 2 * qb + 3;
    const int my_last = DEC ? 17 : 1 + (qpos0 >> 6);
    bf16x8 q[4];
    { const bf16* qp = P.Qb + (R0 + r32) * 512 + h * 128 + c * 64 + 8 * hi;
#pragma unroll
      for (int ks = 0; ks < 4; ++ks) q[ks] = *(const bf16x8*)(qp + 16 * ks); }
    const int skey = tid >> 4, sch = tid & 15;
    const unsigned kdst = (unsigned)(skey * 256 + ((sch ^ (skey & 15)) << 4));
    const unsigned vdst = (unsigned)(AT_V + skey * 256 + (((sch >> 2) ^ (skey & 3)) << 6) + (sch & 3) * 16);
    const size_t ssrc = (size_t)skey * 512 + sch * 8;
    u32x4 kreg[2], vreg[2];
#define AT_ROWOFF(t) ((t) == 0 ? 0 : NMETA + 64 * ((t) - 1))
#define AT_GLOAD(t) do { const size_t ro_ = (size_t)AT_ROWOFF(t) * 512 + ssrc; \
        kreg[0] = *(const u32x4*)(Kg + ro_); kreg[1] = *(const u32x4*)(Kg + ro_ + 32 * 512); vreg[0] = *(const u32x4*)(Vg + ro_); vreg[1] = *(const u32x4*)(Vg + ro_ + 32 * 512); } while (0)
#define AT_LWRITE(buf) do { LAS unsigned char* d_ = lds + (buf) * AT_BUF; \
        *(LAS u32x4*)(d_ + kdst) = kreg[0]; *(LAS u32x4*)(d_ + kdst + 8192) = kreg[1]; *(LAS u32x4*)(d_ + vdst) = vreg[0]; *(LAS u32x4*)(d_ + vdst + 8192) = vreg[1]; } while (0)
    unsigned kofs[4];
#pragma unroll
    for (int ks = 0; ks < 4; ++ks) kofs[ks] = (unsigned)(r32 * 256 + (((c * 8 + 2 * ks + hi) ^ (r32 & 15)) << 4));
    const int q4 = (lane & 15) >> 2;
    unsigned vofs[4];
#pragma unroll
    for (int dg = 0; dg < 4; ++dg) vofs[dg] = (unsigned)(AT_V + (4 * hi + q4) * 256 + ((dg ^ q4) << 6) + ((lane >> 4) & 1) * 32 + (lane & 3) * 8);
    const LAS float* lut = (const LAS float*)(lds + AT_LUT) + h * 256;

    f32x16 O[4];
#pragma unroll
    for (int dg = 0; dg < 4; ++dg)
#pragma unroll
        for (int r = 0; r < 16; ++r) O[dg][r] = 0.f;
    float m_run = -INFINITY, l_run = 0.f;

    AT_GLOAD(0); AT_LWRITE(0);
    __syncthreads();
    for (int t = 0; t < NT; ++t) {
        const bool more = (t + 1 < NT);
        if (more) AT_GLOAD(t + 1);
        if (active && t <= my_last) {
            const LAS unsigned char* kb = lds + (t & 1) * AT_BUF;
            const int nv = (t == 0) ? 16 : ((DEC && t == 17) ? 32 : 64);
            const int kpos0 = (t == 0) ? -NMETA : 64 * (t - 1);
            f32x16 s0, s1;
            if (kpos0 + nv - 1 - qpos0 >= -90) {
                const LAS float* lp = lut + (kpos0 - qpos0 - r32 + 4 * hi + 192);
#pragma unroll
                for (int r = 0; r < 16; ++r) { s0[r] = lp[(r & 3) + 8 * (r >> 2)]; s1[r] = lp[32 + (r & 3) + 8 * (r >> 2)]; }
            } else {
#pragma unroll
                for (int r = 0; r < 16; ++r) { s0[r] = 0.f; s1[r] = 0.f; }
            }
#pragma unroll
            for (int ks = 0; ks < 4; ++ks) {
                const bf16x8 a0 = *(const LAS bf16x8*)(kb + kofs[ks]);
                s0 = __builtin_amdgcn_mfma_f32_32x32x16_bf16(a0, q[ks], s0, 0, 0, 0);
                if (nv > 32) { const bf16x8 a1 = *(const LAS bf16x8*)(kb + kofs[ks] + 8192); s1 = __builtin_amdgcn_mfma_f32_32x32x16_bf16(a1, q[ks], s1, 0, 0, 0); }
            }
            if (nv == 16) {
#pragma unroll
                for (int r = 8; r < 16; ++r) s0[r] = -INFINITY;
            }
            if (nv <= 32) {
#pragma unroll
                for (int r = 0; r < 16; ++r) s1[r] = -INFINITY;
            }
            float mx = fmaxf(s0[0], s1[0]);
#pragma unroll
            for (int r = 1; r < 16; ++r) mx = fmaxf(mx, fmaxf(s0[r], s1[r]));
            mx = fmaxf(mx, swap32f(mx));
            const float mnew = fmaxf(m_run, mx);
            if (__any(mnew > m_run)) {
                const float alpha = ex2(m_run - mnew); l_run *= alpha;
#pragma unroll
                for (int dg = 0; dg < 4; ++dg)
#pragma unroll
                    for (int r = 0; r < 16; ++r) O[dg][r] *= alpha;
                m_run = mnew;
            }
            float ls = 0.f;
#pragma unroll
            for (int r = 0; r < 16; ++r) { s0[r] = ex2(s0[r] - m_run); s1[r] = ex2(s1[r] - m_run); ls += s0[r] + s1[r]; }
            l_run += ls;
            bf16x8 pf[4];
#pragma unroll
            for (int k2 = 0; k2 < 2; ++k2) {
                u32x4 w0, w1;
                w0.x = pk2(s0[8 * k2 + 0], s0[8 * k2 + 1]); w0.y = pk2(s0[8 * k2 + 2], s0[8 * k2 + 3]); w0.z = pk2(s0[8 * k2 + 4], s0[8 * k2 + 5]); w0.w = pk2(s0[8 * k2 + 6], s0[8 * k2 + 7]);
                w1.x = pk2(s1[8 * k2 + 0], s1[8 * k2 + 1]); w1.y = pk2(s1[8 * k2 + 2], s1[8 * k2 + 3]); w1.z = pk2(s1[8 * k2 + 4], s1[8 * k2 + 5]); w1.w = pk2(s1[8 * k2 + 6], s1[8 * k2 + 7]);
                pf[k2] = __builtin_bit_cast(bf16x8, w0); pf[2 + k2] = __builtin_bit_cast(bf16x8, w1);
            }
            const int nks = nv >> 4;
#pragma unroll
            for (int ks = 0; ks < 4; ++ks) {
                if (ks < nks) {
#pragma unroll
                    for (int dg = 0; dg < 4; ++dg) {
                        const s16x4 lo = vtr(kb + vofs[dg] + ks * 4096), hh = vtr(kb + vofs[dg] + ks * 4096 + 2048);
                        const bf16x8 vf = (bf16x8){lo[0], lo[1], lo[2], lo[3], hh[0], hh[1], hh[2], hh[3]};
                        O[dg] = __builtin_amdgcn_mfma_f32_32x32x16_bf16(vf, pf[ks], O[dg], 0, 0, 0);
                    }
                }
            }
        }
        if (more) AT_LWRITE((t + 1) & 1);
        __syncthreads();
    }
#undef AT_ROWOFF
#undef AT_GLOAD
#undef AT_LWRITE
    const float lt = l_run + swap32f(l_run);
    const float sc = (c == 0 ? 1.0f : lam) / lt;
    LAS float* xch = (LAS float*)(lds + AT_XCH) + g * 4096 + lane;
    if (active && c == 1) {
#pragma unroll
        for (int dg = 0; dg < 4; ++dg)
#pragma unroll
            for (int r = 0; r < 16; ++r) xch[(dg * 16 + r) * 64] = O[dg][r] * sc;
    }
    __syncthreads();
    if (active && c == 0) {
        float ss = 0.f;
#pragma unroll
        for (int dg = 0; dg < 4; ++dg)
#pragma unroll
            for (int r = 0; r < 16; ++r) { const float o = O[dg][r] * sc - xch[(dg * 16 + r) * 64]; O[dg][r] = o; ss += o * o; }
        ss += swap32f(ss);
        const float rs = (1.0f - LAM_INIT) / sqrtf(ss * (1.f / 128.f) + EPS);
        const size_t R = R0 + r32;
#pragma unroll
        for (int dg = 0; dg < 4; ++dg)
#pragma unroll
            for (int k = 0; k < 4; ++k) {
                const int dv0 = 32 * dg + 8 * k + 4 * hi;
                const f32x4 gg = *(const f32x4*)(P.sg + dv0);
                const u32x2 za = *(const u32x2*)(P.ZA + R * 512 + h * 128 + dv0);
                u32x2 w;
                w.x = pk2(O[dg][4 * k + 0] * rs * gg.x * bflo(za.x), O[dg][4 * k + 1] * rs * gg.y * bfhi(za.x));
                w.y = pk2(O[dg][4 * k + 2] * rs * gg.z * bflo(za.y), O[dg][4 * k + 3] * rs * gg.w * bfhi(za.y));
                *(u32x2*)(P.Mb + R * D + h * 128 + dv0) = w;
            }
    }
}
__device__ __forceinline__ f32x4 unpk_lo(const u32x4 v) { return (f32x4){bflo(v.x), bfhi(v.x), bflo(v.y), bfhi(v.y)}; }
__device__ __forceinline__ f32x4 unpk_hi(const u32x4 v) { return (f32x4){bflo(v.z), bfhi(v.z), bflo(v.w), bfhi(v.w)}; }
__device__ __forceinline__ void conv_row(const Ptrs& P, int R, int lane) {
    const int c0 = lane * 8;
    f32x4 a0, a1, b0, b1, d0, d1;
    if (R < R_DEC) { const int b = R / SEQ, t = R % SEQ; const bf16* cp = P.CUb + ((size_t)b * KVP + NMETA + t) * 512 + c0;
        const u32x4 x0 = *(const u32x4*)(cp - 1024), x1 = *(const u32x4*)(cp - 512), x2 = *(const u32x4*)cp;
        a0 = unpk_lo(x0); a1 = unpk_hi(x0); b0 = unpk_lo(x1); b1 = unpk_hi(x1); d0 = unpk_lo(x2); d1 = unpk_hi(x2);
    } else { const int r = R - R_DEC, b = r / DS, t = r % DS; const bf16* cp = P.CUd + (size_t)r * 512 + c0;
        const u32x4 x2 = *(const u32x4*)cp; d0 = unpk_lo(x2); d1 = unpk_hi(x2);
        if (t >= 1) { const u32x4 x1 = *(const u32x4*)(cp - 512); b0 = unpk_lo(x1); b1 = unpk_hi(x1); }
        else { const float* sp = P.sc + ((size_t)b * 2 + 1) * 512 + c0; b0 = *(const f32x4*)sp; b1 = *(const f32x4*)(sp + 4); }
        if (t >= 2) { const u32x4 x0 = *(const u32x4*)(cp - 1024); a0 = unpk_lo(x0); a1 = unpk_hi(x0); }
        else { const float* sp = P.sc + ((size_t)b * 2 + t) * 512 + c0; a0 = *(const f32x4*)sp; a1 = *(const f32x4*)(sp + 4); }
    }
    const f32x4 w00 = *(const f32x4*)(P.cw + c0), w01 = *(const f32x4*)(P.cw + c0 + 4), w10 = *(const f32x4*)(P.cw + 512 + c0), w11 = *(const f32x4*)(P.cw + 512 + c0 + 4),
                w20 = *(const f32x4*)(P.cw + 1024 + c0), w21 = *(const f32x4*)(P.cw + 1024 + c0 + 4);
    const u32x4 gv = *(const u32x4*)(P.Gb + (size_t)R * 512 + c0);
    const f32x4 y0 = unpk_lo(gv) * (w00 * a0 + w10 * b0 + w20 * d0), y1 = unpk_hi(gv) * (w01 * a1 + w11 * b1 + w21 * d1);
    *(u32x4*)(P.Mb + (size_t)R * D + 512 + c0) = pack8(y0, y1);
}
__device__ __forceinline__ void p2_attention(const Ptrs& P, LAS unsigned char* lds, int blk, int G, int wave, int lane) {
    for (int i = threadIdx.x; i < NH * 256; i += NWAVES * 64) { const int h = i >> 8, rel = (i & 255) - 192;
        ((LAS float*)(lds + AT_LUT))[i] = (P.relb[rel_bucket(rel) * NH + h] - P.relb[15 * NH + h]) * LOG2E; }
    const float d1 = wave_sum(P.lq1[lane] * P.lk1[lane]), d2 = wave_sum(P.lq2[lane] * P.lk2[lane]);
    const float lam = expf(d1) - expf(d2) + LAM_INIT;
    __syncthreads();
#ifndef NO_CONV
    { const int gw = blk * NWAVES + wave, NGW = G * NWAVES; for (int R = gw; R < R_META; R += NGW) conv_row(P, R, lane); }
#endif
    const int npair = NB * NH * 16;
    const int ndec = (blk < DB * NH) ? (DB * NH - 1 - blk) / G + 1 : 0;
    const bool xmap = (G % 8 == 0) && (npair % G) == 0;
    const int npr = xmap ? (npair / G) : ((blk < npair) ? (npair - 1 - blk) / G + 1 : 0);
#pragma unroll 1
    for (int i = 0; i < ndec + 2 * npr; ++i) {
        if (i < ndec) { const int u = blk + i * G; attn_unit(true, P, lds, u >> 2, u & 3, 0, lam, wave, lane); }
        else { const int ii = (i - ndec) >> 1, second = (i - ndec) & 1;
            const int p = xmap ? (blk % 8) * (npair / 8) + blk / 8 + ii * (G / 8) : blk + ii * G;
            const int bh = p >> 4, j = p & 15;
            attn_unit(false, P, lds, bh >> 2, bh & 3, second ? j : 31 - j, lam, wave, lane); }
    }
}
__device__ __forceinline__ void p4_final_norm(const Ptrs& P, int blk, int G, int wave, int lane) {
    const int gw = blk * NWAVES + wave, NGW = G * NWAVES;
    for (int R = gw; R < R_META; R += NGW) {
        float ss; float* y;
        if (R < R_DEC) { ss = lane < 16 ? P.part[(size_t)R * 16 + lane] : 0.f; y = P.out + O_YP + (size_t)R * D; }
        else { ss = P.partD[(R - R_DEC) * 64 + lane]; y = P.out + O_YS + (size_t)(R - R_DEC) * D; }
        const float rstd = 1.0f / sqrtf(wave_sum(ss) * (1.f / D) + EPS);
        f32x4* yr = (f32x4*)y + lane; const f32x4* gr = (const f32x4*)P.fg + lane;
#pragma unroll
        for (int j = 0; j < 4; ++j) yr[64 * j] = yr[64 * j] * rstd * gr[64 * j];
    }
}

struct Args { const float* in[17]; float* out; unsigned char* ws; int ph_lo, ph_hi; };
__global__ void __launch_bounds__(NWAVES * 64, 2) fwd_kernel(Args a) {
    extern __shared__ __attribute__((aligned(16))) unsigned char lds_raw[];
    LAS unsigned char* lds = (LAS unsigned char*)lds_raw;
    const int tid = threadIdx.x, lane = tid & 63, wave = __builtin_amdgcn_readfirstlane(tid >> 6);
    const int G = gridDim.x, blk = blockIdx.x;
    const int vcu = (G % 8 == 0) ? (blk % 8) * (G / 8) + blk / 8 : blk;
    Ptrs P;
    P.xp = a.in[0]; P.xs = a.in[1]; P.ck = a.in[2]; P.cv = a.in[3]; P.sc = a.in[4]; P.meta = a.in[5]; P.relb = a.in[6]; P.ng = a.in[7]; P.win = a.in[8]; P.cw = a.in[9];
    P.lq1 = a.in[10]; P.lk1 = a.in[11]; P.lq2 = a.in[12]; P.lk2 = a.in[13]; P.sg = a.in[14]; P.wout = a.in[15]; P.fg = a.in[16];
    P.out = a.out;
    unsigned char* ws = a.ws;
    P.WtIn = (bf16*)(ws + WS_WIN); P.WtOut = (bf16*)(ws + WS_WOUT); P.XN = (bf16*)(ws + WS_XN); P.Qb = (bf16*)(ws + WS_Q); P.ZA = (bf16*)(ws + WS_ZA); P.Gb = (bf16*)(ws + WS_G);
    P.Kb = (bf16*)(ws + WS_K); P.Vb = (bf16*)(ws + WS_V); P.CUb = (bf16*)(ws + WS_CU); P.KbD = (bf16*)(ws + WS_KD); P.VbD = (bf16*)(ws + WS_VD); P.CUd = (bf16*)(ws + WS_CUD); P.Mb = (bf16*)(ws + WS_M);
    P.part = (float*)(ws + WS_PART); P.partD = (float*)(ws + WS_PARTD);
    const int lo = a.ph_lo, hi = a.ph_hi;
#ifndef PHASE_MASK
#define PHASE_MASK 31
#endif
#define IN(k) (((PHASE_MASK >> (k)) & 1) && lo <= (k) && (k) < hi)
#define SEAM(k) do { if (IN(k) && IN((k) + 1)) { cg::this_grid().sync(); } } while (0)
    if (IN(0)) { p0_prologue(P, lds, vcu, G, wave, lane); }
    SEAM(0);
    if (IN(1)) {
        pg8::Gemm g{P.XN, P.WtIn, MFR, WIN, D}; pg8::StaticOrder S; S.init(MFR, WIN, G, blk);
        EpiIn E{P.Qb, P.ZA, P.Gb, P.Kb, P.Vb, P.CUb, P.out};
#ifndef NO_BIG
        pg8::gemm_phase<EpiIn, pg8::StaticOrder, true, true>(lds, g, S, E);
#endif
#ifndef NO_SMALL
        for (int j = blk; j < 256; j += G) small_in_tile(P, lds, j, wave, lane);
#endif
    }
    SEAM(1);
    if (IN(2)) { p2_attention(P, lds, blk, G, wave, lane); }
    SEAM(2);
    if (IN(3)) {
        pg8::Gemm g{P.Mb, P.WtOut, MFR, D, D}; pg8::StaticOrder S; S.init(MFR, D, G, blk);
        EpiOut E{P.xp, P.out + O_YP, P.part};
        pg8::gemm_phase<EpiOut, pg8::StaticOrder, true, true>(lds, g, S, E);
        for (int j = blk; j < 256; j += G) small_out_tile(P, lds, j, wave, lane);
    }
    SEAM(3);
    if (IN(4)) { p4_final_norm(P, blk, G, wave, lane); }
#undef IN
#undef SEAM
}

extern "C" void kernel_launch(void* const* d_in, const int* in_sizes, int n_in, void* d_out, int out_size, void* d_ws, size_t ws_size, hipStream_t stream) {
    static int grid = 0;
    if (grid == 0) {
        if (n_in != 17 || (size_t)out_size != O_END || ws_size < WS_END) { fprintf(stderr, "kernel_launch: unexpected shapes (n_in %d out %d ws %zu)\n", n_in, out_size, ws_size); grid = -1; return; }
        int dev = 0, cus = 0, per_cu = 0;
        if (hipGetDevice(&dev) != hipSuccess || hipDeviceGetAttribute(&cus, hipDeviceAttributeMultiprocessorCount, dev) != hipSuccess) { grid = -1; return; }
        if (hipFuncSetAttribute((const void*)fwd_kernel, hipFuncAttributeMaxDynamicSharedMemorySize, LDS_BYTES) != hipSuccess) { fprintf(stderr, "kernel_launch: hipFuncSetAttribute failed\n"); grid = -1; return; }
        if (hipOccupancyMaxActiveBlocksPerMultiprocessor(&per_cu, (const void*)fwd_kernel, NWAVES * 64, LDS_BYTES) != hipSuccess || per_cu < 1) { fprintf(stderr, "kernel_launch: occupancy query says %d\n", per_cu); per_cu = 1; }
        (void)hipGetLastError();
        grid = cus;
        fprintf(stderr, "kernel_launch: cus %d per_cu %d grid %d\n", cus, per_cu, grid);
    }
    if (grid < 0) return;
    Args a{};
    for (int i = 0; i < 17; ++i) a.in[i] = (const float*)d_in[i];
    a.out = (float*)d_out; a.ws = (unsigned char*)d_ws;
#if N_LAUNCHES == 1
    a.ph_lo = 0; a.ph_hi = 5;
    void* args[] = {&a};
    hipError_t e = hipLaunchCooperativeKernel((void*)fwd_kernel, dim3(grid), dim3(NWAVES * 64), args, LDS_BYTES, stream);
    if (e != hipSuccess) fprintf(stderr, "kernel_launch: cooperative launch failed: %s (grid %d)\n", hipGetErrorString(e), grid);
#else
    for (int p = 0; p < 5; ++p) { a.ph_lo = p; a.ph_hi = p + 1; hipLaunchKernelGGL(fwd_kernel, dim3(grid), dim3(NWAVES * 64), LDS_BYTES, stream, a); }
#endif
}
```

```cpp
#include <hip/hip_runtime.h>

#include <cstdio>
#include <cstdint>

namespace pg8 {
#define PG8_LAS __attribute__((address_space(3)))
typedef unsigned short bf16_t;
typedef short bf16x8 __attribute__((ext_vector_type(8)));
typedef float f32x4 __attribute__((ext_vector_type(4)));
typedef unsigned u32x4 __attribute__((ext_vector_type(4)));
constexpr int BM = 256, BK = 64, HALF = 128, HTB = HALF * BK * 2  , STAGE_BYTES = 8 * HTB, NXCD = 8, WGM = 8;

__host__ __device__ __forceinline__ int lds_byte(int r, int c) { const int st = (r >> 4) * 2 + (c >> 5), rr = r & 15, cc = c & 31, ob = rr * 64 + cc * 2; return st * 1024 + (ob ^ (((ob >> 9) & 1) << 5)); }
__host__ __device__ __forceinline__ void stage_rc(int b, int& R, int& C) { const int st = b / 1024, sb = b % 1024, swz = sb ^ (((sb >> 9) & 1) << 5); R = (st >> 1) * 16 + swz / 64; C = (st & 1) * 32 + (swz % 64) / 2; }
__host__ __device__ __forceinline__ int perm32(int rho) { const int n = rho >> 4, i = rho & 15; return 8 * (i >> 2) + 4 * n + (i & 3); }

struct Unit { int pm, pn; };
struct Gemm { const bf16_t* A; const bf16_t* Bt; int M, N, K; };

struct StaticOrder {
    int nM, nN, nwg, G, c;
    __host__ __device__ void init(int M, int N, int G_, int c_) { nM = M / BM; nN = N / BM; nwg = nM * nN; G = G_; c = c_; }
    __host__ __device__ bool next(int i, Unit& u) const {
        const long L = (long)i * G + c; if (L >= nwg) return false;
        int wgid = (int)L; { const int q = nwg / NXCD, r = nwg % NXCD, xcd = wgid % NXCD, off = wgid / NXCD; wgid = (xcd < r ? xcd * (q + 1) : r * (q + 1) + (xcd - r) * q) + off; }
        const int nig = WGM * nN, gid = wgid / nig, fm = gid * WGM, gsz = (nM - fm) < WGM ? (nM - fm) : WGM;
        u.pm = fm + ((wgid % nig) % gsz); u.pn = (wgid % nig) / gsz; return true;
    }
    __device__ __forceinline__ void a_ready(const Unit&) const {}
    __device__ __forceinline__ void done(const Unit&) const {}
};
template <class Epi, class Sched, bool ALIGN_EPI = false, bool SP2 = false>
__device__ __forceinline__ void gemm_phase(PG8_LAS unsigned char* lds, const Gemm g, const Sched& S, const Epi& E) {
    const int tid = threadIdx.x, wid = __builtin_amdgcn_readfirstlane(tid >> 6), lane = tid & 63, wr = wid >> 2, wc = wid & 3, fr = lane & 15, fq = lane >> 4;
    const int K = g.K, nt = K / BK;
    unsigned voffA[2], voffB[2];
#pragma unroll
    for (int i = 0; i < 2; ++i) { int R, C; stage_rc(tid * 16 + i * 8192, R, C); const int Rb = Epi::PERM ? ((R & ~31) + perm32(R & 31)) : R;
        voffA[i] = (unsigned)(R * K + C) * 2u; voffB[i] = (unsigned)(Rb * K + C) * 2u; }
    const size_t kstep = (size_t)(BK * 2);
    const size_t hstep = (size_t)HALF * K * 2;
    const size_t tstep = 2 * hstep;
    const unsigned ldsw = (unsigned)wid * 1024u;
    const int aoff = lds_byte(wr * 64 + fr, fq * 8), boff = lds_byte(wc * 32 + fr, fq * 8);
#define PG8_SA(b, h) (((b) * 2 + (h)) * HTB)
#define PG8_SB(b, h) ((4 + (b) * 2 + (h)) * HTB)
#define PG8_STAGE(bufoff, gbase, voff) do { _Pragma("unroll") for (int _i = 0; _i < 2; ++_i) \
        __builtin_amdgcn_global_load_lds((const unsigned*)((const char*)(gbase) + (voff)[_i]), (PG8_LAS unsigned*)(lds + (bufoff) + ldsw + _i * 8192), 16, 0, 0); } while (0)
#define PG8_LDA(dst, b, h) do { _Pragma("unroll") for (int m = 0; m < 4; ++m) _Pragma("unroll") for (int k = 0; k < 2; ++k) dst[m][k] = *(const PG8_LAS bf16x8*)(lds + PG8_SA(b, h) + aoff + m * 2048 + k * 1024); } while (0)
#define PG8_LDB(dst, b, h) do { _Pragma("unroll") for (int n = 0; n < 2; ++n) _Pragma("unroll") for (int k = 0; k < 2; ++k) dst[n][k] = *(const PG8_LAS bf16x8*)(lds + PG8_SB(b, h) + boff + n * 2048 + k * 1024); } while (0)
#define PG8_MMA(ai, bj, At, Bt) do { __builtin_amdgcn_s_setprio(1); _Pragma("unroll") for (int m = 0; m < 4; ++m) _Pragma("unroll") for (int n = 0; n < 2; ++n) _Pragma("unroll") for (int k = 0; k < 2; ++k) \
        acc[ai][bj][m][n] = __builtin_amdgcn_mfma_f32_16x16x32_bf16(Bt[n][k], At[m][k], acc[ai][bj][m][n], 0, 0, 0); __builtin_amdgcn_s_setprio(0); } while (0)
#define PG8_WAIT_V(n) asm volatile("s_waitcnt vmcnt(" #n ")" ::: "memory")
#define PG8_WAIT_L(n) asm volatile("s_waitcnt lgkmcnt(" #n ")" ::: "memory")
#define PG8_BAR __builtin_amdgcn_s_barrier()
#define PG8_SCHED __builtin_amdgcn_sched_barrier(0)
    Unit cur, nxt; int ui = 0;
    if (!S.next(0, cur)) return;
    f32x4 acc[2][2][4][2];
#pragma unroll
    for (int a = 0; a < 2; ++a)
#pragma unroll
        for (int b = 0; b < 2; ++b)
#pragma unroll
            for (int m = 0; m < 4; ++m)
#pragma unroll
                for (int n = 0; n < 2; ++n) acc[a][b][m][n] = (f32x4){0.f, 0.f, 0.f, 0.f};
    bf16x8 At[4][2], B0[2][2], B1[2][2];
    const char* cA = (const char*)g.A + (size_t)cur.pm * tstep; const char* cB = (const char*)g.Bt + (size_t)cur.pn * tstep;
    S.a_ready(cur);
    if constexpr (SP2) {
        PG8_STAGE(PG8_SB(0, 0), cB, voffB); PG8_STAGE(PG8_SB(0, 1), cB + hstep, voffB); PG8_STAGE(PG8_SA(0, 0), cA, voffA); PG8_STAGE(PG8_SA(0, 1), cA + hstep, voffA);
        if (wr == 1) PG8_BAR;
        PG8_WAIT_V(2); PG8_BAR;
        PG8_STAGE(PG8_SB(1, 0), cB + kstep, voffB); PG8_STAGE(PG8_SA(1, 0), cA + kstep, voffA); PG8_STAGE(PG8_SB(1, 1), cB + hstep + kstep, voffB);
        PG8_WAIT_V(6); PG8_BAR;
    } else {
        PG8_STAGE(PG8_SB(0, 0), cB, voffB); PG8_STAGE(PG8_SA(0, 0), cA, voffA); PG8_STAGE(PG8_SB(0, 1), cB + hstep, voffB); PG8_STAGE(PG8_SA(0, 1), cA + hstep, voffA);
        if (wr == 1) PG8_BAR;
        PG8_WAIT_V(4); PG8_BAR;
        PG8_STAGE(PG8_SB(1, 0), cB + kstep, voffB); PG8_STAGE(PG8_SA(1, 0), cA + kstep, voffA); PG8_STAGE(PG8_SB(1, 1), cB + hstep + kstep, voffB);
        PG8_WAIT_V(6); PG8_BAR;
    }
    for (;;) {
        const bool has_next = S.next(ui + 1, nxt);
        const char* nA = has_next ? (const char*)g.A + (size_t)nxt.pm * tstep : cA; const char* nB = has_next ? (const char*)g.Bt + (size_t)nxt.pn * tstep : cB;
        for (int t = 0; t < nt; t += 2) {
            const bool last = (t == nt - 2);
            const char* a1 = cA + (size_t)(t + 1) * kstep;
            const char* a2 = last ? nA : cA + (size_t)(t + 2) * kstep; const char* b2 = last ? nB : cB + (size_t)(t + 2) * kstep;
            const char* a3 = a2 + kstep; const char* b3 = b2 + kstep;
            if (last && has_next) S.a_ready(nxt);
            if constexpr (SP2) {
            PG8_LDB(B0, 0, 0); PG8_LDB(B1, 0, 1); PG8_SCHED; PG8_LDA(At, 0, 0); PG8_STAGE(PG8_SA(1, 1), a1 + hstep, voffA);
            PG8_WAIT_V(8); PG8_WAIT_L(0); PG8_BAR; PG8_MMA(0, 0, At, B0); PG8_MMA(0, 1, At, B1); PG8_BAR; PG8_SCHED;
            PG8_LDA(At, 0, 1); PG8_STAGE(PG8_SB(0, 0), b2, voffB); PG8_STAGE(PG8_SB(0, 1), b2 + hstep, voffB); PG8_STAGE(PG8_SA(0, 0), a2, voffA);
            PG8_WAIT_V(8); PG8_WAIT_L(0); PG8_BAR; PG8_MMA(1, 0, At, B0); PG8_MMA(1, 1, At, B1); PG8_BAR; PG8_SCHED;
            PG8_LDB(B0, 1, 0); PG8_LDB(B1, 1, 1); PG8_SCHED; PG8_LDA(At, 1, 0); PG8_STAGE(PG8_SA(0, 1), a2 + hstep, voffA);
            PG8_WAIT_V(8); PG8_WAIT_L(0); PG8_BAR; PG8_MMA(0, 0, At, B0); PG8_MMA(0, 1, At, B1); PG8_BAR; PG8_SCHED;
            PG8_LDA(At, 1, 1); PG8_STAGE(PG8_SB(1, 0), b3, voffB); PG8_STAGE(PG8_SB(1, 1), b3 + hstep, voffB); PG8_STAGE(PG8_SA(1, 0), a3, voffA);
            PG8_WAIT_V(8); PG8_WAIT_L(0); PG8_BAR; PG8_MMA(1, 0, At, B0); PG8_MMA(1, 1, At, B1); PG8_BAR; PG8_SCHED;
            } else {
            PG8_LDB(B0, 0, 0); PG8_SCHED; PG8_LDA(At, 0, 0); PG8_STAGE(PG8_SA(1, 1), a1 + hstep, voffA);
            PG8_WAIT_L(8); PG8_BAR; PG8_WAIT_L(0); PG8_MMA(0, 0, At, B0); PG8_BAR; PG8_SCHED;
            PG8_LDB(B1, 0, 1); PG8_STAGE(PG8_SB(0, 0), b2, voffB);
            PG8_BAR; PG8_WAIT_L(0); PG8_MMA(0, 1, At, B1); PG8_BAR;
            PG8_LDA(At, 0, 1); PG8_STAGE(PG8_SA(0, 0), a2, voffA);
            PG8_BAR; PG8_WAIT_L(0); PG8_MMA(1, 0, At, B0); PG8_BAR; PG8_SCHED;
            PG8_STAGE(PG8_SB(0, 1), b2 + hstep, voffB);
            PG8_WAIT_V(6); PG8_BAR; PG8_MMA(1, 1, At, B1); PG8_BAR;
            PG8_LDB(B0, 1, 0); PG8_SCHED; PG8_LDA(At, 1, 0); PG8_STAGE(PG8_SA(0, 1), a2 + hstep, voffA);
            PG8_WAIT_L(8); PG8_BAR; PG8_WAIT_L(0); PG8_MMA(0, 0, At, B0); PG8_BAR; PG8_SCHED;
            PG8_LDB(B1, 1, 1); PG8_STAGE(PG8_SB(1, 0), b3, voffB);
            PG8_BAR; PG8_WAIT_L(0); PG8_MMA(0, 1, At, B1); PG8_BAR;
            PG8_LDA(At, 1, 1); PG8_STAGE(PG8_SA(1, 0), a3, voffA);
            PG8_BAR; PG8_WAIT_L(0); PG8_MMA(1, 0, At, B0); PG8_BAR; PG8_SCHED;
            PG8_STAGE(PG8_SB(1, 1), b3 + hstep, voffB);
            PG8_WAIT_V(6); PG8_BAR; PG8_MMA(1, 1, At, B1); PG8_BAR;
            }
        }
        if constexpr (ALIGN_EPI) { if (wr == 0) PG8_BAR; }
        if constexpr (!Epi::AFTER_DRAIN) { E(acc, cur, wr, wc, fr, fq); S.done(cur); }
        if (!has_next) break;
#pragma unroll
        for (int a = 0; a < 2; ++a)
#pragma unroll
            for (int b = 0; b < 2; ++b)
#pragma unroll
                for (int m = 0; m < 4; ++m)
#pragma unroll
                    for (int n = 0; n < 2; ++n) acc[a][b][m][n] = (f32x4){0.f, 0.f, 0.f, 0.f};
        cur = nxt; cA = nA; cB = nB; ++ui;
        if constexpr (ALIGN_EPI) { if (wr == 1) PG8_BAR; }
    }
    PG8_WAIT_V(0);
    if constexpr (!ALIGN_EPI) { if (wr == 0) PG8_BAR; }
    PG8_BAR;
    if constexpr (Epi::AFTER_DRAIN) { E.fused(acc, cur, wr, wc, fr, fq, lds, wid, lane); S.done(cur); }
#undef PG8_SA
#undef PG8_SB
#undef PG8_STAGE
#undef PG8_LDA
#undef PG8_LDB
#undef PG8_MMA
#undef PG8_WAIT_V
#undef PG8_WAIT_L
#undef PG8_BAR
#undef PG8_SCHED
}
}

#ifndef N_LAUNCHES
#define N_LAUNCHES 1
#endif
constexpr int D = 1024, NB = 8, SEQ = 4096, DB = 8, DS = 32, PAST = 1024, NMETA = 16, NH = 4;
constexpr int MFR = NB * SEQ;
constexpr int MDR = DB * DS;
constexpr int R_DEC = MFR, R_META = MFR + MDR, R_ALL = R_META + NMETA;
constexpr int KVP = NMETA + SEQ;
constexpr int KVD = NMETA + PAST + DS;
constexpr int WIN = 4096;
constexpr float EPS = 1e-6f;
constexpr float LOG2E = 1.4426950408889634f;
constexpr float QSCALE = 0.125f * LOG2E;
constexpr float LAM_INIT = 0.2f;
constexpr size_t O_YP = 0, O_YS = 33554432, O_KP = 33816576, O_VP = 50659328, O_CP = 67502080, O_KS = 67510272, O_VS = 67641344, O_CS = 67772416, O_END = 67780608;
constexpr size_t MiB = 1u << 20;
constexpr size_t WS_PART = 1 * MiB;
constexpr size_t WS_PARTD = 3 * MiB;
constexpr size_t WS_WIN = 4 * MiB;
constexpr size_t WS_WOUT = 12 * MiB;
constexpr size_t WS_XN = 16 * MiB;
constexpr size_t WS_Q = 96 * MiB;
constexpr size_t WS_ZA = 132 * MiB;
constexpr size_t WS_G = 168 * MiB;
constexpr size_t WS_K = 204 * MiB;
constexpr size_t WS_V = 240 * MiB;
constexpr size_t WS_CU = 276 * MiB;
constexpr size_t WS_KD = 312 * MiB;
constexpr size_t WS_VD = 324 * MiB;
constexpr size_t WS_CUD = 336 * MiB;
constexpr size_t WS_M = 340 * MiB;
constexpr size_t WS_END = 408 * MiB;

constexpr int LDS_BYTES = 147456;
constexpr int NWAVES = 8;

#define LAS __attribute__((address_space(3)))
typedef unsigned short bf16;
typedef unsigned u32x4 __attribute__((ext_vector_type(4)));
typedef unsigned u32x2 __attribute__((ext_vector_type(2)));
typedef float f32x4 __attribute__((ext_vector_type(4)));
typedef float f32x2 __attribute__((ext_vector_type(2)));
typedef float f32x16 __attribute__((ext_vector_type(16)));
typedef short bf16x8 __attribute__((ext_vector_type(8)));
typedef short s16x4 __attribute__((ext_vector_type(4)));
typedef __bf16 bf16x2_t __attribute__((ext_vector_type(2)));

__device__ __forceinline__ unsigned pk2(float lo, float hi) { f32x2 v = {lo, hi}; bf16x2_t b = __builtin_convertvector(v, bf16x2_t); return __builtin_bit_cast(unsigned, b); }
__device__ __forceinline__ bf16 f2bf(float f) { return (bf16)(pk2(f, 0.f) & 0xffffu); }
__device__ __forceinline__ float bf2f(unsigned short b) { return __builtin_bit_cast(float, ((unsigned)b) << 16); }
__device__ __forceinline__ float bflo(unsigned w) { return __builtin_bit_cast(float, w << 16); }
__device__ __forceinline__ float bfhi(unsigned w) { return __builtin_bit_cast(float, w & 0xffff0000u); }
__device__ __forceinline__ float ex2(float x) { return __builtin_amdgcn_exp2f(x); }
__device__ __forceinline__ float silu(float x) { return x * __builtin_amdgcn_rcpf(1.0f + ex2(-x * LOG2E)); }
__device__ __forceinline__ float wave_sum(float v) {
#pragma unroll
    for (int o = 1; o < 64; o <<= 1) v += __shfl_xor(v, o);
    return v;
}
__device__ __forceinline__ float swap32f(float v) { return __shfl_xor(v, 32); }
#define LDS_WAIT() asm volatile("s_waitcnt lgkmcnt(0)" ::: "memory")

struct Ptrs {
    const float *xp, *xs, *ck, *cv, *sc, *meta, *relb, *ng, *win, *cw, *lq1, *lk1, *lq2, *lk2, *sg, *wout, *fg;
    float* out;
    bf16 *WtIn, *WtOut, *XN, *Qb, *ZA, *Gb, *Kb, *Vb, *CUb, *KbD, *VbD, *CUd, *Mb;
    float *part, *partD;
};

__device__ __forceinline__ int win_src_col(int n) {
    if (n < 2048) return n;
    if (n < 3072) { const int u = (n - 2048) >> 8, w = (n - 2048) & 255; return w < 128 ? 2048 + 128 * u + w : 3584 + 128 * u + (w - 128); }
    const int u = (n - 3072) >> 8, w = (n - 3072) & 255; return w < 128 ? 2560 + 128 * u + w : 3072 + 128 * u + (w - 128);
}
__device__ __forceinline__ void p0_transpose_item(const float* W, int N, int K, bf16* WT, int n_src0, int n_dst0, int k0, LAS float* scr, int lane) {
#pragma unroll 8
    for (int i = 0; i < 32; ++i) { const int kk = 2 * i + (lane >> 5); scr[kk * 33 + (lane & 31)] = W[(size_t)(k0 + kk) * N + n_src0 + (lane & 31)]; }
    LDS_WAIT(); asm volatile("" ::: "memory");
    const int c = lane & 7;
#pragma unroll
    for (int j = 0; j < 4; ++j) { const int n = (lane >> 3) + 8 * j; const LAS float* s = scr + (8 * c) * 33 + n;
        u32x4 o; o.x = pk2(s[0 * 33], s[1 * 33]); o.y = pk2(s[2 * 33], s[3 * 33]); o.z = pk2(s[4 * 33], s[5 * 33]); o.w = pk2(s[6 * 33], s[7 * 33]);
        *(u32x4*)(WT + (size_t)(n_dst0 + n) * K + k0 + 8 * c) = o; }
    LDS_WAIT(); asm volatile("" ::: "memory");
}
__device__ __forceinline__ void rms_row_to_bf16(const float* xrow, const float* g, bf16* orow, int lane) {
    const f32x4* xr = (const f32x4*)xrow + lane; const f32x4* gr = (const f32x4*)g + lane;
    f32x4 v[4]; float s = 0.f;
#pragma unroll
    for (int j = 0; j < 4; ++j) { v[j] = xr[64 * j]; s += (v[j].x * v[j].x + v[j].y * v[j].y) + (v[j].z * v[j].z + v[j].w * v[j].w); }
    const float rstd = 1.0f / sqrtf(wave_sum(s) * (1.f / D) + EPS);
    u32x2* o8 = (u32x2*)orow + lane;
#pragma unroll
    for (int j = 0; j < 4; ++j) { const f32x4 gg = gr[64 * j]; u32x2 o; o.x = pk2(v[j].x * rstd * gg.x, v[j].y * rstd * gg.y); o.y = pk2(v[j].z * rstd * gg.z, v[j].w * rstd * gg.w); o8[64 * j] = o; }
}
__device__ __forceinline__ void p0_prologue(const Ptrs& P, LAS unsigned char* lds, int vcu, int G, int wave, int lane) {
    LAS float* scr = (LAS float*)(lds + wave * 16384);
    const int gw = vcu * NWAVES + wave, NGW = G * NWAVES;
    constexpr int I_IN = (D / 64) * (WIN / 32), I_OUT = (D / 64) * (D / 32);
    for (int it = gw; it < I_IN + I_OUT; it += NGW) {
        if (it < I_IN) { const int kb = it / (WIN / 32), nb = it % (WIN / 32); p0_transpose_item(P.win, WIN, D, P.WtIn, win_src_col(32 * nb), 32 * nb, 64 * kb, scr, lane); }
        else { const int r = it - I_IN, kb = r / (D / 32), nb = r % (D / 32); p0_transpose_item(P.wout, D, D, P.WtOut, 32 * nb, 32 * nb, 64 * kb, scr, lane); }
    }
    for (int R = gw; R < R_ALL; R += NGW) {
        const float* xr = R < R_DEC ? P.xp + (size_t)R * D : (R < R_META ? P.xs + (size_t)(R - R_DEC) * D : P.meta + (size_t)(R - R_META) * D);
        rms_row_to_bf16(xr, P.ng, P.XN + (size_t)R * D, lane);
    }
    constexpr int CROWS = DB * (NMETA + PAST);
    for (int it = gw; it < 2 * CROWS; it += NGW) {
        const int isv = it >= CROWS, r = isv ? it - CROWS : it, b = r / (NMETA + PAST), j = r % (NMETA + PAST);
        const float* src = (isv ? P.cv : P.ck) + (size_t)r * 512 + lane * 8;
        bf16* dst = (isv ? P.VbD : P.KbD) + ((size_t)b * KVD + j) * 512 + lane * 8;
        const f32x4 a = *(const f32x4*)src, c = *(const f32x4*)(src + 4);
        u32x4 o; o.x = pk2(a.x, a.y); o.y = pk2(a.z, a.w); o.z = pk2(c.x, c.y); o.w = pk2(c.z, c.w);
        *(u32x4*)dst = o;
    }
}

__device__ __forceinline__ u32x4 pack8(const f32x4 a, const f32x4 b) { u32x4 w; w.x = pk2(a.x, a.y); w.y = pk2(a.z, a.w); w.z = pk2(b.x, b.y); w.w = pk2(b.z, b.w); return w; }
__device__ __forceinline__ f32x4 silu4(const f32x4 a) { return (f32x4){silu(a.x), silu(a.y), silu(a.z), silu(a.w)}; }
struct EpiIn {
    static constexpr bool PERM = true, AFTER_DRAIN = false;
    bf16 *Qb, *ZA, *Gb, *Kb, *Vb, *CUb; float* out;
    __device__ __forceinline__ void operator()(const f32x4 (&acc)[2][2][4][2], const pg8::Unit& u, int wr, int wc, int fr, int fq) const {
        const int typ = u.pn >> 1;
        const int b = u.pm >> 4, t0 = (u.pm & 15) * 256 + wr * 64 + fr;
        const size_t rowA0 = (size_t)u.pm * 256 + wr * 64 + fr, kvrow0 = (size_t)b * KVP + NMETA + t0;
        if (typ == 0) {
            const int col = (u.pn & 1) * 256 + wc * 32 + 8 * fq;
#pragma unroll
            for (int ai = 0; ai < 2; ++ai)
#pragma unroll
                for (int m = 0; m < 4; ++m) { bf16* rp = Qb + (rowA0 + ai * 128 + m * 16) * 512 + col;
#pragma unroll
                    for (int bj = 0; bj < 2; ++bj) *(u32x4*)(rp + bj * 128) = pack8(acc[ai][bj][m][0] * QSCALE, acc[ai][bj][m][1] * QSCALE); }
        } else if (typ == 1 || typ == 2) {
            const int col = (u.pn & 1) * 256 + wc * 32 + 8 * fq;
            float* o = out + (typ == 1 ? O_KP : O_VP); bf16* kb = typ == 1 ? Kb : Vb;
#pragma unroll
            for (int ai = 0; ai < 2; ++ai)
#pragma unroll
                for (int m = 0; m < 4; ++m) { const size_t off = (kvrow0 + ai * 128 + m * 16) * 512 + col;
#pragma unroll
                    for (int bj = 0; bj < 2; ++bj) { *(f32x4*)(o + off + bj * 128) = acc[ai][bj][m][0]; *(f32x4*)(o + off + bj * 128 + 4) = acc[ai][bj][m][1];
                        *(u32x4*)(kb + off + bj * 128) = pack8(acc[ai][bj][m][0], acc[ai][bj][m][1]); } }
        } else if (typ == 3) {
            const int col = (u.pn & 1) * 256 + wc * 32 + 8 * fq;
#pragma unroll
            for (int ai = 0; ai < 2; ++ai)
#pragma unroll
                for (int m = 0; m < 4; ++m) { bf16* rp = ZA + (rowA0 + ai * 128 + m * 16) * 512 + col;
#pragma unroll
                    for (int bj = 0; bj < 2; ++bj) *(u32x4*)(rp + bj * 128) = pack8(silu4(acc[ai][bj][m][0]), silu4(acc[ai][bj][m][1])); }
        } else if (typ < 6) {
            const int col = (u.pn - 8) * 128 + wc * 32 + 8 * fq;
#pragma unroll
            for (int ai = 0; ai < 2; ++ai)
#pragma unroll
                for (int m = 0; m < 4; ++m)
                    *(u32x4*)(Gb + (rowA0 + ai * 128 + m * 16) * 512 + col) = pack8(silu4(acc[ai][1][m][0]) * acc[ai][0][m][0], silu4(acc[ai][1][m][1]) * acc[ai][0][m][1]);
        } else {
            const int col = (u.pn - 12) * 128 + wc * 32 + 8 * fq;
#pragma unroll
            for (int ai = 0; ai < 2; ++ai)
#pragma unroll
                for (int m = 0; m < 4; ++m) { const f32x4 c0 = acc[ai][0][m][0] * acc[ai][1][m][0], c1 = acc[ai][0][m][1] * acc[ai][1][m][1];
                    *(u32x4*)(CUb + (kvrow0 + ai * 128 + m * 16) * 512 + col) = pack8(c0, c1);
                    const int t = t0 + ai * 128 + m * 16;
                    if (t >= SEQ - 2) { float* cp = out + O_CP + ((size_t)b * 2 + (t - (SEQ - 2))) * 512 + col; *(f32x4*)cp = c0; *(f32x4*)(cp + 4) = c1; } }
        }
    }
};
struct EpiOut {
    static constexpr bool PERM = true, AFTER_DRAIN = false;
    const float* x; float* y; float* part;
    __device__ __forceinline__ void operator()(const f32x4 (&acc)[2][2][4][2], const pg8::Unit& u, int wr, int wc, int fr, int fq) const {
        const size_t row0 = (size_t)u.pm * 256 + wr * 64 + fr; const int col = u.pn * 256 + wc * 32 + 8 * fq;
#pragma unroll
        for (int ai = 0; ai < 2; ++ai)
#pragma unroll
            for (int m = 0; m < 4; ++m) { const size_t row = row0 + ai * 128 + m * 16, off = row * D + col; float ss = 0.f;
#pragma unroll
                for (int bj = 0; bj < 2; ++bj) {
                    const f32x4 h0 = *(const f32x4*)(x + off + bj * 128) + acc[ai][bj][m][0], h1 = *(const f32x4*)(x + off + bj * 128 + 4) + acc[ai][bj][m][1];
                    *(f32x4*)(y + off + bj * 128) = h0; *(f32x4*)(y + off + bj * 128 + 4) = h1;
                    ss += (h0.x * h0.x + h0.y * h0.y) + (h0.z * h0.z + h0.w * h0.w) + (h1.x * h1.x + h1.y * h1.y) + (h1.z * h1.z + h1.w * h1.w); }
                ss += __shfl_xor(ss, 16); ss += __shfl_xor(ss, 32);
                if (fq == 0) part[row * 16 + u.pn * 4 + wc] = ss; }
    }
};

template <int MFN>
__device__ __forceinline__ void small_mma_stage(const bf16* A, const bf16* Bt, int brow, LAS unsigned char* lds, int wave, int lane) {
    const int col = lane & 15, kq = lane >> 4;
    const bf16* bp = Bt + (size_t)brow * D + 128 * wave + 8 * kq;
    bf16x8 bfrag[4];
#pragma unroll
    for (int ks = 0; ks < 4; ++ks) bfrag[ks] = *(const bf16x8*)(bp + 32 * ks);
    __syncthreads();
    const bf16* ap = A + (size_t)col * D + 128 * wave + 8 * kq;
#pragma unroll 2
    for (int mf = 0; mf < MFN; ++mf) {
        f32x4 acc = (f32x4){0.f, 0.f, 0.f, 0.f};
#pragma unroll
        for (int ks = 0; ks < 4; ++ks) acc = __builtin_amdgcn_mfma_f32_16x16x32_bf16(*(const bf16x8*)(ap + (size_t)mf * 16 * D + 32 * ks), bfrag[ks], acc, 0, 0, 0);
        *(LAS f32x4*)(lds + ((wave * MFN + mf) * 64 + lane) * 16) = acc;
    }
    __syncthreads();
}
template <int MFN>
__device__ __forceinline__ f32x4 small_reduce(LAS unsigned char* lds, int mf, int lane) {
    f32x4 s = (f32x4){0.f, 0.f, 0.f, 0.f};
#pragma unroll
    for (int w = 0; w < 8; ++w) s += *(const LAS f32x4*)(lds + ((w * MFN + mf) * 64 + lane) * 16);
    return s;
}
__device__ __forceinline__ void small_in_tile(const Ptrs& P, LAS unsigned char* lds, int j, int wave, int lane) {
    const int col = lane & 15;
    int np;
    if (j < 128) np = 16 * j + col; else { const int jj = j - 128; np = 2048 + 256 * (jj >> 4) + 8 * (jj & 15) + (col & 7) + 128 * (col >> 3); }
    small_mma_stage<17>(P.XN + (size_t)R_DEC * D, P.WtIn, np, lds, wave, lane);
#pragma unroll 1
    for (int mf = wave; mf < 17; mf += 8) {
        const f32x4 res = small_reduce<17>(lds, mf, lane);
#pragma unroll
        for (int i = 0; i < 4; ++i) {
            const float v = res[i]; const float other = __shfl_xor(v, 8);
            const int rr = 16 * mf + 4 * (lane >> 4) + i;
            if (mf < 16) {
                const int b = rr >> 5, t = rr & 31; const size_t R = (size_t)R_DEC + rr;
                if (j < 128) { const int typ = np >> 9, cc = np & 511;
                    if (typ == 0) P.Qb[R * 512 + cc] = f2bf(v * QSCALE);
                    else if (typ == 1) { P.out[O_KS + (size_t)rr * 512 + cc] = v; P.KbD[((size_t)b * KVD + NMETA + PAST + t) * 512 + cc] = f2bf(v); }
                    else if (typ == 2) { P.out[O_VS + (size_t)rr * 512 + cc] = v; P.VbD[((size_t)b * KVD + NMETA + PAST + t) * 512 + cc] = f2bf(v); }
                    else P.ZA[R * 512 + cc] = f2bf(silu(v));
                } else if (col < 8) { const int jq = j - 128, u8 = jq >> 4, c = 128 * (u8 & 3) + 8 * (jq & 15) + col;
                    if (u8 < 4) P.Gb[R * 512 + c] = f2bf(silu(other) * v);
                    else { const float cu = v * other; P.CUd[(size_t)rr * 512 + c] = f2bf(cu); if (t >= DS - 2) P.out[O_CS + ((size_t)b * 2 + (t - (DS - 2))) * 512 + c] = cu; }
                }
            } else {
                const int m = rr - 256;
                if (j < 128) { const int typ = np >> 9, cc = np & 511;
                    if (typ == 1 || typ == 2) { float* o = P.out + (typ == 1 ? O_KP : O_VP); bf16* kb = typ == 1 ? P.Kb : P.Vb; const bf16 vb = f2bf(v);
                        for (int b = 0; b < NB; ++b) { const size_t off = ((size_t)b * KVP + m) * 512 + cc; o[off] = v; kb[off] = vb; } }
                } else if (col < 8) { const int jq = j - 128, u8 = jq >> 4, c = 128 * (u8 & 3) + 8 * (jq & 15) + col;
                    if (u8 >= 4) { const bf16 cb = f2bf(v * other); for (int b = 0; b < NB; ++b) P.CUb[((size_t)b * KVP + m) * 512 + c] = cb; } }
            }
        }
    }
}
__device__ __forceinline__ void small_out_tile(const Ptrs& P, LAS unsigned char* lds, int j, int wave, int lane) {
    const int rg = j >> 6, cg_ = j & 63, col = lane & 15, n = 16 * cg_ + col;
    small_mma_stage<4>(P.Mb + (size_t)(R_DEC + 64 * rg) * D, P.WtOut, n, lds, wave, lane);
    if (wave < 4) {
        const f32x4 res = small_reduce<4>(lds, wave, lane);
#pragma unroll
        for (int i = 0; i < 4; ++i) { const int r = 64 * rg + 16 * wave + 4 * (lane >> 4) + i;
            const float h = P.xs[(size_t)r * D + n] + res[i]; P.out[O_YS + (size_t)r * D + n] = h;
            float ss = h * h; ss += __shfl_xor(ss, 1); ss += __shfl_xor(ss, 2); ss += __shfl_xor(ss, 4); ss += __shfl_xor(ss, 8);
            if (col == 0) P.partD[r * 64 + cg_] = ss; }
    }
}

constexpr int AT_BUF = 32768, AT_V = 16384, AT_LUT = 65536, AT_XCH = 73728;
__device__ __forceinline__ int crow(int r, int hi) { return (r & 3) + 8 * (r >> 2) + 4 * hi; }
__device__ __forceinline__ int rel_bucket(int rel) {
    const int n = rel < 0 ? -rel : rel; int v;
    if (n < 8) v = n; else if (n < 12) v = 8; else if (n < 16) v = 9; else if (n < 23) v = 10; else if (n < 32) v = 11; else if (n < 46) v = 12; else if (n < 64) v = 13; else if (n < 91) v = 14; else v = 15;
    return (rel > 0 ? 16 : 0) + v;
}
__device__ __forceinline__ s16x4 vtr(const LAS unsigned char* p) { return __builtin_bit_cast(s16x4, __builtin_amdgcn_ds_read_tr16_b64_v4i16((LAS s16x4*)p)); }

__device__ __forceinline__ void attn_unit(const bool DEC, const Ptrs& P, LAS unsigned char* lds, int b, int h, int qb, float lam, int wave, int lane) {
    const int tid = threadIdx.x, g = wave >> 1, c = wave & 1, r32 = lane & 31, hi = lane >> 5;
    const int qpos0 = DEC ? PAST : 128 * qb + 32 * g;
    const size_t R0 = DEC ? (size_t)R_DEC + b * DS : (size_t)b * SEQ + qpos0;
    const bool active = DEC ? (g == 0) : true;
    const bf16* Kg = (DEC ? P.KbD + (size_t)b * KVD * 512 : P.Kb + (size_t)b * KVP * 512) + h * 128;
    const bf16* Vg = (DEC ? P.VbD + (size_t)b * KVD * 512 : P.Vb + (size_t)b * KVP * 512) + h * 128;
    const int NT = DEC ? 18 : 2 * qb + 3;
    const int my_last = DEC ? 17 : 1 + (qpos0 >> 6);
    bf16x8 q[4];
    { const bf16* qp = P.Qb + (R0 + r32) * 512 + h * 128 + c * 64 + 8 * hi;
#pragma unroll
      for (int ks = 0; ks < 4; ++ks) q[ks] = *(const bf16x8*)(qp + 16 * ks); }
    const int skey = tid >> 4, sch = tid & 15;
    const unsigned kdst = (unsigned)(skey * 256 + ((sch ^ (skey & 15)) << 4));
    const unsigned vdst = (unsigned)(AT_V + skey * 256 + (((sch >> 2) ^ (skey & 3)) << 6) + (sch & 3) * 16);
    const size_t ssrc = (size_t)skey * 512 + sch * 8;
    u32x4 kreg[2], vreg[2];
#define AT_ROWOFF(t) ((t) == 0 ? 0 : NMETA + 64 * ((t) - 1))
#define AT_GLOAD(t) do { const size_t ro_ = (size_t)AT_ROWOFF(t) * 512 + ssrc; \
        kreg[0] = *(const u32x4*)(Kg + ro_); kreg[1] = *(const u32x4*)(Kg + ro_ + 32 * 512); vreg[0] = *(const u32x4*)(Vg + ro_); vreg[1] = *(const u32x4*)(Vg + ro_ + 32 * 512); } while (0)
#define AT_LWRITE(buf) do { LAS unsigned char* d_ = lds + (buf) * AT_BUF; \
        *(LAS u32x4*)(d_ + kdst) = kreg[0]; *(LAS u32x4*)(d_ + kdst + 8192) = kreg[1]; *(LAS u32x4*)(d_ + vdst) = vreg[0]; *(LAS u32x4*)(d_ + vdst + 8192) = vreg[1]; } while (0)
    unsigned kofs[4];
#pragma unroll
    for (int ks = 0; ks < 4; ++ks) kofs[ks] = (unsigned)(r32 * 256 + (((c * 8 + 2 * ks + hi) ^ (r32 & 15)) << 4));
    const int q4 = (lane & 15) >> 2;
    unsigned vofs[4];
#pragma unroll
    for (int dg = 0; dg < 4; ++dg) vofs[dg] = (unsigned)(AT_V + (4 * hi + q4) * 256 + ((dg ^ q4) << 6) + ((lane >> 4) & 1) * 32 + (lane & 3) * 8);
    const LAS float* lut = (const LAS float*)(lds + AT_LUT) + h * 256;

    f32x16 O[4];
#pragma unroll
    for (int dg = 0; dg < 4; ++dg)
#pragma unroll
        for (int r = 0; r < 16; ++r) O[dg][r] = 0.f;
    float m_run = -INFINITY, l_run = 0.f;

    AT_GLOAD(0); AT_LWRITE(0);
    __syncthreads();
    for (int t = 0; t < NT; ++t) {
        const bool more = (t + 1 < NT);
        if (more) AT_GLOAD(t + 1);
        if (active && t <= my_last) {
            const LAS unsigned char* kb = lds + (t & 1) * AT_BUF;
            const int nv = (t == 0) ? 16 : ((DEC && t == 17) ? 32 : 64);
            const int kpos0 = (t == 0) ? -NMETA : 64 * (t - 1);
            f32x16 s0, s1;
            if (kpos0 + nv - 1 - qpos0 >= -90) {
                const LAS float* lp = lut + (kpos0 - qpos0 - r32 + 4 * hi + 192);
#pragma unroll
                for (int r = 0; r < 16; ++r) { s0[r] = lp[(r & 3) + 8 * (r >> 2)]; s1[r] = lp[32 + (r & 3) + 8 * (r >> 2)]; }
            } else {
#pragma unroll
                for (int r = 0; r < 16; ++r) { s0[r] = 0.f; s1[r] = 0.f; }
            }
#pragma unroll
            for (int ks = 0; ks < 4; ++ks) {
                const bf16x8 a0 = *(const LAS bf16x8*)(kb + kofs[ks]);
                s0 = __builtin_amdgcn_mfma_f32_32x32x16_bf16(a0, q[ks], s0, 0, 0, 0);
                if (nv > 32) { const bf16x8 a1 = *(const LAS bf16x8*)(kb + kofs[ks] + 8192); s1 = __builtin_amdgcn_mfma_f32_32x32x16_bf16(a1, q[ks], s1, 0, 0, 0); }
            }
            if (nv == 16) {
#pragma unroll
                for (int r = 8; r < 16; ++r) s0[r] = -INFINITY;
            }
            if (nv <= 32) {
#pragma unroll
                for (int r = 0; r < 16; ++r) s1[r] = -INFINITY;
            }
            float mx = fmaxf(s0[0], s1[0]);
#pragma unroll
            for (int r = 1; r < 16; ++r) mx = fmaxf(mx, fmaxf(s0[r], s1[r]));
            mx = fmaxf(mx, swap32f(mx));
            const float mnew = fmaxf(m_run, mx);
            if (__any(mnew > m_run)) {
                const float alpha = ex2(m_run - mnew); l_run *= alpha;
#pragma unroll
                for (int dg = 0; dg < 4; ++dg)
#pragma unroll
                    for (int r = 0; r < 16; ++r) O[dg][r] *= alpha;
                m_run = mnew;
            }
            float ls = 0.f;
#pragma unroll
            for (int r = 0; r < 16; ++r) { s0[r] = ex2(s0[r] - m_run); s1[r] = ex2(s1[r] - m_run); ls += s0[r] + s1[r]; }
            l_run += ls;
            bf16x8 pf[4];
#pragma unroll
            for (int k2 = 0; k2 < 2; ++k2) {
                u32x4 w0, w1;
                w0.x = pk2(s0[8 * k2 + 0], s0[8 * k2 + 1]); w0.y = pk2(s0[8 * k2 + 2], s0[8 * k2 + 3]); w0.z = pk2(s0[8 * k2 + 4], s0[8 * k2 + 5]); w0.w = pk2(s0[8 * k2 + 6], s0[8 * k2 + 7]);
                w1.x = pk2(s1[8 * k2 + 0], s1[8 * k2 + 1]); w1.y = pk2(s1[8 * k2 + 2], s1[8 * k2 + 3]); w1.z = pk2(s1[8 * k2 + 4], s1[8 * k2 + 5]); w1.w = pk2(s1[8 * k2 + 6], s1[8 * k2 + 7]);
                pf[k2] = __builtin_bit_cast(bf16x8, w0); pf[2 + k2] = __builtin_bit_cast(bf16x8, w1);
            }
            const int nks = nv >> 4;
#pragma unroll
            for (int ks = 0; ks < 4; ++ks) {
                if (ks < nks) {
#pragma unroll
                    for (int dg = 0; dg < 4; ++dg) {
                        const s16x4 lo = vtr(kb + vofs[dg] + ks * 4096), hh = vtr(kb + vofs[dg] + ks * 4096 + 2048);
                        const bf16x8 vf = (bf16x8){lo[0], lo[1], lo[2], lo[3], hh[0], hh[1], hh[2], hh[3]};
                        O[dg] = __builtin_amdgcn_mfma_f32_32x32x16_bf16(vf, pf[ks], O[dg], 0, 0, 0);
                    }
                }
            }
        }
        if (more) AT_LWRITE((t + 1) & 1);
        __syncthreads();
    }
#undef AT_ROWOFF
#undef AT_GLOAD
#undef AT_LWRITE
    const float lt = l_run + swap32f(l_run);
    const float sc = (c == 0 ? 1.0f : lam) / lt;
    LAS float* xch = (LAS float*)(lds + AT_XCH) + g * 4096 + lane;
    if (active && c == 1) {
#pragma unroll
        for (int dg = 0; dg < 4; ++dg)
#pragma unroll
            for (int r = 0; r < 16; ++r) xch[(dg * 16 + r) * 64] = O[dg][r] * sc;
    }
    __syncthreads();
    if (active && c == 0) {
        float ss = 0.f;
#pragma unroll
        for (int dg = 0; dg < 4; ++dg)
#pragma unroll
            for (int r = 0; r < 16; ++r) { const float o = O[dg][r] * sc - xch[(dg * 16 + r) * 64]; O[dg][r] = o; ss += o * o; }
        ss += swap32f(ss);
        const float rs = (1.0f - LAM_INIT) / sqrtf(ss * (1.f / 128.f) + EPS);
        const size_t R = R0 + r32;
#pragma unroll
        for (int dg = 0; dg < 4; ++dg)
#pragma unroll
            for (int k = 0; k < 4; ++k) {
                const int dv0 = 32 * dg + 8 * k + 4 * hi;
                const f32x4 gg = *(const f32x4*)(P.sg + dv0);
                const u32x2 za = *(const u32x2*)(P.ZA + R * 512 + h * 128 + dv0);
                u32x2 w;
                w.x = pk2(O[dg][4 * k + 0] * rs * gg.x * bflo(za.x), O[dg][4 * k + 1] * rs * gg.y * bfhi(za.x));
                w.y = pk2(O[dg][4 * k + 2] * rs * gg.z * bflo(za.y), O[dg][4 * k + 3] * rs * gg.w * bfhi(za.y));
                *(u32x2*)(P.Mb + R * D + h * 128 + dv0) = w;
            }
    }
}
__device__ __forceinline__ f32x4 unpk_lo(const u32x4 v) { return (f32x4){bflo(v.x), bfhi(v.x), bflo(v.y), bfhi(v.y)}; }
__device__ __forceinline__ f32x4 unpk_hi(const u32x4 v) { return (f32x4){bflo(v.z), bfhi(v.z), bflo(v.w), bfhi(v.w)}; }
__device__ __forceinline__ void conv_row(const Ptrs& P, int R, int lane) {
    const int c0 = lane * 8;
    f32x4 a0, a1, b0, b1, d0, d1;
    if (R < R_DEC) { const int b = R / SEQ, t = R % SEQ; const bf16* cp = P.CUb + ((size_t)b * KVP + NMETA + t) * 512 + c0;
        const u32x4 x0 = *(const u32x4*)(cp - 1024), x1 = *(const u32x4*)(cp - 512), x2 = *(const u32x4*)cp;
        a0 = unpk_lo(x0); a1 = unpk_hi(x0); b0 = unpk_lo(x1); b1 = unpk_hi(x1); d0 = unpk_lo(x2); d1 = unpk_hi(x2);
    } else { const int r = R - R_DEC, b = r / DS, t = r % DS; const bf16* cp = P.CUd + (size_t)r * 512 + c0;
        const u32x4 x2 = *(const u32x4*)cp; d0 = unpk_lo(x2); d1 = unpk_hi(x2);
        if (t >= 1) { const u32x4 x1 = *(const u32x4*)(cp - 512); b0 = unpk_lo(x1); b1 = unpk_hi(x1); }
        else { const float* sp = P.sc + ((size_t)b * 2 + 1) * 512 + c0; b0 = *(const f32x4*)sp; b1 = *(const f32x4*)(sp + 4); }
        if (t >= 2) { const u32x4 x0 = *(const u32x4*)(cp - 1024); a0 = unpk_lo(x0); a1 = unpk_hi(x0); }
        else { const float* sp = P.sc + ((size_t)b * 2 + t) * 512 + c0; a0 = *(const f32x4*)sp; a1 = *(const f32x4*)(sp + 4); }
    }
    const f32x4 w00 = *(const f32x4*)(P.cw + c0), w01 = *(const f32x4*)(P.cw + c0 + 4), w10 = *(const f32x4*)(P.cw + 512 + c0), w11 = *(const f32x4*)(P.cw + 512 + c0 + 4),
                w20 = *(const f32x4*)(P.cw + 1024 + c0), w21 = *(const f32x4*)(P.cw + 1024 + c0 + 4);
    const u32x4 gv = *(const u32x4*)(P.Gb + (size_t)R * 512 + c0);
    const f32x4 y0 = unpk_lo(gv) * (w00 * a0 + w10 * b0 + w20 * d0), y1 = unpk_hi(gv) * (w01 * a1 + w11 * b1 + w21 * d1);
    *(u32x4*)(P.Mb + (size_t)R * D + 512 + c0) = pack8(y0, y1);
}
__device__ __forceinline__ void p2_attention(const Ptrs& P, LAS unsigned char* lds, int blk, int G, int wave, int lane) {
    for (int i = threadIdx.x; i < NH * 256; i += NWAVES * 64) { const int h = i >> 8, rel = (i & 255) - 192;
        ((LAS float*)(lds + AT_LUT))[i] = (P.relb[rel_bucket(rel) * NH + h] - P.relb[15 * NH + h]) * LOG2E; }
    const float d1 = wave_sum(P.lq1[lane] * P.lk1[lane]), d2 = wave_sum(P.lq2[lane] * P.lk2[lane]);
    const float lam = expf(d1) - expf(d2) + LAM_INIT;
    __syncthreads();
#ifndef NO_CONV
    { const int gw = blk * NWAVES + wave, NGW = G * NWAVES; for (int R = gw; R < R_META; R += NGW) conv_row(P, R, lane); }
#endif
    const int npair = NB * NH * 16;
    const int ndec = (blk < DB * NH) ? (DB * NH - 1 - blk) / G + 1 : 0;
    const bool xmap = (G % 8 == 0) && (npair % G) == 0;
    const int npr = xmap ? (npair / G) : ((blk < npair) ? (npair - 1 - blk) / G + 1 : 0);
#pragma unroll 1
    for (int i = 0; i < ndec + 2 * npr; ++i) {
        if (i < ndec) { const int u = blk + i * G; attn_unit(true, P, lds, u >> 2, u & 3, 0, lam, wave, lane); }
        else { const int ii = (i - ndec) >> 1, second = (i - ndec) & 1;
            const int p = xmap ? (blk % 8) * (npair / 8) + blk / 8 + ii * (G / 8) : blk + ii * G;
            const int bh = p >> 4, j = p & 15;
            attn_unit(false, P, lds, bh >> 2, bh & 3, second ? j : 31 - j, lam, wave, lane); }
    }
}
__device__ __forceinline__ void p4_final_norm(const Ptrs& P, int blk, int G, int wave, int lane) {
    const int gw = blk * NWAVES + wave, NGW = G * NWAVES;
    for (int R = gw; R < R_META; R += NGW) {
        float ss; float* y;
        if (R < R_DEC) { ss = lane < 16 ? P.part[(size_t)R * 16 + lane] : 0.f; y = P.out + O_YP + (size_t)R * D; }
        else { ss = P.partD[(R - R_DEC) * 64 + lane]; y = P.out + O_YS + (size_t)(R - R_DEC) * D; }
        const float rstd = 1.0f / sqrtf(wave_sum(ss) * (1.f / D) + EPS);
        f32x4* yr = (f32x4*)y + lane; const f32x4* gr = (const f32x4*)P.fg + lane;
#pragma unroll
        for (int j = 0; j < 4; ++j) yr[64 * j] = yr[64 * j] * rstd * gr[64 * j];
    }
}

constexpr size_t WS_CTL = 0, CTL_ZERO_BYTES = 131072;
constexpr int LDSCTL_OFF = 139264;
#define XB_TMO      128
#define XB_XCNT(j)  (256  + 64 * (j))
#define XB_XSUB(j)  (1280 + 64 * (j))
#define XB_XGEN(j)  (2304 + 64 * (j))
#define XB_TOP      3328
#define XB_TOPGEN   3392
#define XCD_BAR_WORDS 3456
#define XB_SPIN_CAP (1u << 18)

__device__ __forceinline__ unsigned xb_ld(unsigned* p)              { return __hip_atomic_load(p, __ATOMIC_RELAXED, __HIP_MEMORY_SCOPE_AGENT); }
__device__ __forceinline__ unsigned xb_add(unsigned* p, unsigned v) { return __hip_atomic_fetch_add(p, v, __ATOMIC_RELAXED, __HIP_MEMORY_SCOPE_AGENT); }
__device__ __forceinline__ unsigned xb_xcc_id() { return (unsigned)__builtin_amdgcn_s_getreg((3 << 11) | 20) & 0xFu; }
#define XB_SPIN(cond, bar) do { unsigned _sp = 0; while (cond) { __builtin_amdgcn_s_sleep(1); \
    if ((++_sp & 255u) == 0u) { if (xb_ld(&(bar)[XB_TMO])) break; if (_sp > XB_SPIN_CAP) { atomicAdd(&(bar)[XB_TMO], 1u); break; } } } } while (0)

struct XcdBarrier {
    unsigned* bar; unsigned x;
    volatile LAS unsigned* st;
};

__device__ __forceinline__ XcdBarrier xcd_barrier_post(unsigned* bar, volatile LAS unsigned* st) {
    XcdBarrier b; b.bar = bar; b.x = xb_xcc_id(); b.st = st;
    if (threadIdx.x == 0) (void)xb_add(&bar[XB_XCNT(b.x)], 1u);
    return b;
}
__device__ __forceinline__ void xcd_barrier_complete(unsigned* bar, unsigned x, unsigned& nloc, unsigned& nx) {
    const unsigned G = gridDim.x * gridDim.y * gridDim.z;
    unsigned sum, cnt, mine, sp = 0u;
    for (;;) {
        sum = 0u; cnt = 0u; mine = 0u;
#pragma unroll
        for (unsigned j = 0; j < 16; ++j) { const unsigned c = xb_ld(&bar[XB_XCNT(j)]); sum += c; cnt += (c > 0u) ? 1u : 0u; mine = (j == x) ? c : mine; }
        if (sum == G) break;
        __builtin_amdgcn_s_sleep(1);
        if ((++sp & 255u) == 0u) { if (xb_ld(&bar[XB_TMO])) break; if (sp > XB_SPIN_CAP) { atomicAdd(&bar[XB_TMO], 1u); break; } }
    }
    nloc = mine > 0u ? mine : 1u; nx = cnt > 0u ? cnt : 1u;
}

__device__ __forceinline__ void xcd_barrier(const XcdBarrier& b) {
    asm volatile("s_waitcnt vmcnt(0)" ::: "memory");
    __syncthreads();
    if (threadIdx.x == 0) {
        unsigned* bar = b.bar;
        __builtin_amdgcn_s_waitcnt(0);
        unsigned nloc = b.st[0], nx = b.st[1];
        if (nloc == 0u) { xcd_barrier_complete(bar, b.x, nloc, nx); b.st[0] = nloc; b.st[1] = nx; }
        const unsigned old = xb_add(&bar[XB_XSUB(b.x)], 1u);
        const unsigned gen = old / nloc;
        if (old + 1u == (gen + 1u) * nloc) {
            __builtin_amdgcn_fence(__ATOMIC_RELEASE, "agent");
            asm volatile("s_waitcnt vmcnt(0)" ::: "memory");
            const unsigned og = xb_add(&bar[XB_TOP], 1u);
            const unsigned tg = og / nx;
            if (og + 1u == (tg + 1u) * nx) xb_add(&bar[XB_TOPGEN], 1u);
            else XB_SPIN(xb_ld(&bar[XB_TOPGEN]) == tg, bar);
            __builtin_amdgcn_fence(__ATOMIC_ACQUIRE, "agent");
            xb_add(&bar[XB_XGEN(b.x)], 1u);
            asm volatile("s_waitcnt vmcnt(0)" ::: "memory");
        } else {
            XB_SPIN(xb_ld(&bar[XB_XGEN(b.x)]) == gen, bar);
            __builtin_amdgcn_fence(__ATOMIC_ACQUIRE, "agent");
            asm volatile("s_waitcnt vmcnt(0)" ::: "memory");
        }
    }
    __syncthreads();
}


struct Args { const float* in[17]; float* out; unsigned char* ws; int ph_lo, ph_hi, li, pad; };
__global__ void __launch_bounds__(NWAVES * 64, 2) fwd_kernel(Args a) {
    extern __shared__ __attribute__((aligned(16))) unsigned char lds_raw[];
    LAS unsigned char* lds = (LAS unsigned char*)lds_raw;
    const int tid = threadIdx.x, lane = tid & 63, wave = __builtin_amdgcn_readfirstlane(tid >> 6);
    const int G = gridDim.x, blk = blockIdx.x;
    const int vcu = (G % 8 == 0) ? (blk % 8) * (G / 8) + blk / 8 : blk;
    Ptrs P;
    P.xp = a.in[0]; P.xs = a.in[1]; P.ck = a.in[2]; P.cv = a.in[3]; P.sc = a.in[4]; P.meta = a.in[5]; P.relb = a.in[6]; P.ng = a.in[7]; P.win = a.in[8]; P.cw = a.in[9];
    P.lq1 = a.in[10]; P.lk1 = a.in[11]; P.lq2 = a.in[12]; P.lk2 = a.in[13]; P.sg = a.in[14]; P.wout = a.in[15]; P.fg = a.in[16];
    P.out = a.out;
    unsigned char* ws = a.ws;
    P.WtIn = (bf16*)(ws + WS_WIN); P.WtOut = (bf16*)(ws + WS_WOUT); P.XN = (bf16*)(ws + WS_XN); P.Qb = (bf16*)(ws + WS_Q); P.ZA = (bf16*)(ws + WS_ZA); P.Gb = (bf16*)(ws + WS_G);
    P.Kb = (bf16*)(ws + WS_K); P.Vb = (bf16*)(ws + WS_V); P.CUb = (bf16*)(ws + WS_CU); P.KbD = (bf16*)(ws + WS_KD); P.VbD = (bf16*)(ws + WS_VD); P.CUd = (bf16*)(ws + WS_CUD); P.Mb = (bf16*)(ws + WS_M);
    P.part = (float*)(ws + WS_PART); P.partD = (float*)(ws + WS_PARTD);
    const int lo = a.ph_lo, hi = a.ph_hi;
    for (int u = tid; u < (LDS_BYTES - LDSCTL_OFF) / 4; u += NWAVES * 64) ((LAS unsigned*)(lds + LDSCTL_OFF))[u] = 0u;
    __syncthreads();
    XcdBarrier bar = xcd_barrier_post((unsigned*)(ws + WS_CTL) + a.li * XCD_BAR_WORDS, (volatile LAS unsigned*)(lds + LDSCTL_OFF) + 8);
#ifndef PHASE_MASK
#define PHASE_MASK 31
#endif
#define IN(k) (((PHASE_MASK >> (k)) & 1) && lo <= (k) && (k) < hi)
#define SEAM(k) do { if (IN(k) && IN((k) + 1)) { xcd_barrier(bar); } } while (0)
    if (IN(0)) { p0_prologue(P, lds, vcu, G, wave, lane); }
    SEAM(0);
    if (IN(1)) {
        pg8::Gemm g{P.XN, P.WtIn, MFR, WIN, D}; pg8::StaticOrder S; S.init(MFR, WIN, G, blk);
        EpiIn E{P.Qb, P.ZA, P.Gb, P.Kb, P.Vb, P.CUb, P.out};
#ifndef NO_BIG
        pg8::gemm_phase<EpiIn, pg8::StaticOrder, true, true>(lds, g, S, E);
#endif
#ifndef NO_SMALL
        for (int j = blk; j < 256; j += G) small_in_tile(P, lds, j, wave, lane);
#endif
    }
    SEAM(1);
    if (IN(2)) { p2_attention(P, lds, blk, G, wave, lane); }
    SEAM(2);
    if (IN(3)) {
        pg8::Gemm g{P.Mb, P.WtOut, MFR, D, D}; pg8::StaticOrder S; S.init(MFR, D, G, blk);
        EpiOut E{P.xp, P.out + O_YP, P.part};
        pg8::gemm_phase<EpiOut, pg8::StaticOrder, true, true>(lds, g, S, E);
        for (int j = blk; j < 256; j += G) small_out_tile(P, lds, j, wave, lane);
    }
    SEAM(3);
    if (IN(4)) { p4_final_norm(P, blk, G, wave, lane); }
#undef IN
#undef SEAM
}

extern "C" void kernel_launch(void* const* d_in, const int* in_sizes, int n_in, void* d_out, int out_size, void* d_ws, size_t ws_size, hipStream_t stream) {
    static int grid = 0;
    if (grid == 0) {
        if (n_in != 17 || (size_t)out_size != O_END || ws_size < WS_END) { fprintf(stderr, "kernel_launch: unexpected shapes (n_in %d out %d ws %zu)\n", n_in, out_size, ws_size); grid = -1; return; }
        int dev = 0, cus = 0, per_cu = 0;
        if (hipGetDevice(&dev) != hipSuccess || hipDeviceGetAttribute(&cus, hipDeviceAttributeMultiprocessorCount, dev) != hipSuccess) { grid = -1; return; }
        if (hipFuncSetAttribute((const void*)fwd_kernel, hipFuncAttributeMaxDynamicSharedMemorySize, LDS_BYTES) != hipSuccess) { fprintf(stderr, "kernel_launch: hipFuncSetAttribute failed\n"); grid = -1; return; }
        if (hipOccupancyMaxActiveBlocksPerMultiprocessor(&per_cu, (const void*)fwd_kernel, NWAVES * 64, LDS_BYTES) != hipSuccess || per_cu < 1) { fprintf(stderr, "kernel_launch: occupancy query says %d\n", per_cu); per_cu = 1; }
        (void)hipGetLastError();
        grid = cus;
        fprintf(stderr, "kernel_launch: cus %d per_cu %d grid %d\n", cus, per_cu, grid);
    }
    if (grid < 0) return;
    Args a{};
    for (int i = 0; i < 17; ++i) a.in[i] = (const float*)d_in[i];
    a.out = (float*)d_out; a.ws = (unsigned char*)d_ws;
    if (hipMemsetAsync((char*)d_ws + WS_CTL, 0, CTL_ZERO_BYTES, stream) != hipSuccess) { fprintf(stderr, "kernel_launch: memset failed\n"); return; }
#if defined(REPEAT_PHASE)
    const int k = REPEAT_PHASE; const int nl = 3; const int lo3[3] = {0, k, k + 1}, hi3[3] = {k + 1, k + 1, 5};
#elif N_LAUNCHES == 1
    const int nl = 1; const int lo3[1] = {0}, hi3[1] = {5};
#else
    const int nl = 5; const int lo3[5] = {0, 1, 2, 3, 4}, hi3[5] = {1, 2, 3, 4, 5};
#endif
    for (int i = 0; i < nl; ++i) { a.ph_lo = lo3[i]; a.ph_hi = hi3[i]; a.li = i;
        hipLaunchKernelGGL(fwd_kernel, dim3(grid), dim3(NWAVES * 64), LDS_BYTES, stream, a);
        const hipError_t le = hipPeekAtLastError();
        if (le != hipSuccess) { fprintf(stderr, "kernel_launch: launch %d failed: %s (grid %d)\n", i, hipGetErrorName(le), grid); break; } }
}
```

```cpp
#include <hip/hip_runtime.h>

#include <cstdio>
#include <cstdint>

namespace pg8 {
#define PG8_LAS __attribute__((address_space(3)))
typedef unsigned short bf16_t;
typedef short bf16x8 __attribute__((ext_vector_type(8)));
typedef float f32x4 __attribute__((ext_vector_type(4)));
typedef unsigned u32x4 __attribute__((ext_vector_type(4)));
constexpr int BM = 256, BK = 64, HALF = 128, HTB = HALF * BK * 2  , STAGE_BYTES = 8 * HTB, NXCD = 8, WGM = 8;

__host__ __device__ __forceinline__ int lds_byte(int r, int c) { const int st = (r >> 4) * 2 + (c >> 5), rr = r & 15, cc = c & 31, ob = rr * 64 + cc * 2; return st * 1024 + (ob ^ (((ob >> 9) & 1) << 5)); }
__host__ __device__ __forceinline__ void stage_rc(int b, int& R, int& C) { const int st = b / 1024, sb = b % 1024, swz = sb ^ (((sb >> 9) & 1) << 5); R = (st >> 1) * 16 + swz / 64; C = (st & 1) * 32 + (swz % 64) / 2; }
__host__ __device__ __forceinline__ int perm32(int rho) { const int n = rho >> 4, i = rho & 15; return 8 * (i >> 2) + 4 * n + (i & 3); }

struct Unit { int pm, pn; };
struct Gemm { const bf16_t* A; const bf16_t* Bt; int M, N, K; };

struct StaticOrder {
    int nM, nN, nwg, G, c;
    __host__ __device__ void init(int M, int N, int G_, int c_) { nM = M / BM; nN = N / BM; nwg = nM * nN; G = G_; c = c_; }
    __host__ __device__ bool next(int i, Unit& u) const {
        const long L = (long)i * G + c; if (L >= nwg) return false;
        int wgid = (int)L; { const int q = nwg / NXCD, r = nwg % NXCD, xcd = wgid % NXCD, off = wgid / NXCD; wgid = (xcd < r ? xcd * (q + 1) : r * (q + 1) + (xcd - r) * q) + off; }
        const int nig = WGM * nN, gid = wgid / nig, fm = gid * WGM, gsz = (nM - fm) < WGM ? (nM - fm) : WGM;
        u.pm = fm + ((wgid % nig) % gsz); u.pn = (wgid % nig) / gsz; return true;
    }
    __device__ __forceinline__ void a_ready(const Unit&) const {}
    __device__ __forceinline__ void done(const Unit&) const {}
};
template <class Epi, class Sched, bool ALIGN_EPI = false, bool SP2 = false>
__device__ __forceinline__ void gemm_phase(PG8_LAS unsigned char* lds, const Gemm g, const Sched& S, const Epi& E) {
    const int tid = threadIdx.x, wid = __builtin_amdgcn_readfirstlane(tid >> 6), lane = tid & 63, wr = wid >> 2, wc = wid & 3, fr = lane & 15, fq = lane >> 4;
    const int K = g.K, nt = K / BK;
    unsigned voffA[2], voffB[2];
#pragma unroll
    for (int i = 0; i < 2; ++i) { int R, C; stage_rc(tid * 16 + i * 8192, R, C); const int Rb = Epi::PERM ? ((R & ~31) + perm32(R & 31)) : R;
        voffA[i] = (unsigned)(R * K + C) * 2u; voffB[i] = (unsigned)(Rb * K + C) * 2u; }
    const size_t kstep = (size_t)(BK * 2);
    const size_t hstep = (size_t)HALF * K * 2;
    const size_t tstep = 2 * hstep;
    const unsigned ldsw = (unsigned)wid * 1024u;
    const int aoff = lds_byte(wr * 64 + fr, fq * 8), boff = lds_byte(wc * 32 + fr, fq * 8);
#define PG8_SA(b, h) (((b) * 2 + (h)) * HTB)
#define PG8_SB(b, h) ((4 + (b) * 2 + (h)) * HTB)
#define PG8_STAGE(bufoff, gbase, voff) do { _Pragma("unroll") for (int _i = 0; _i < 2; ++_i) \
        __builtin_amdgcn_global_load_lds((const unsigned*)((const char*)(gbase) + (voff)[_i]), (PG8_LAS unsigned*)(lds + (bufoff) + ldsw + _i * 8192), 16, 0, 0); } while (0)
#define PG8_LDA(dst, b, h) do { _Pragma("unroll") for (int m = 0; m < 4; ++m) _Pragma("unroll") for (int k = 0; k < 2; ++k) dst[m][k] = *(const PG8_LAS bf16x8*)(lds + PG8_SA(b, h) + aoff + m * 2048 + k * 1024); } while (0)
#define PG8_LDB(dst, b, h) do { _Pragma("unroll") for (int n = 0; n < 2; ++n) _Pragma("unroll") for (int k = 0; k < 2; ++k) dst[n][k] = *(const PG8_LAS bf16x8*)(lds + PG8_SB(b, h) + boff + n * 2048 + k * 1024); } while (0)
#define PG8_MMA(ai, bj, At, Bt) do { __builtin_amdgcn_s_setprio(1); _Pragma("unroll") for (int m = 0; m < 4; ++m) _Pragma("unroll") for (int n = 0; n < 2; ++n) _Pragma("unroll") for (int k = 0; k < 2; ++k) \
        acc[ai][bj][m][n] = __builtin_amdgcn_mfma_f32_16x16x32_bf16(Bt[n][k], At[m][k], acc[ai][bj][m][n], 0, 0, 0); __builtin_amdgcn_s_setprio(0); } while (0)
#define PG8_WAIT_V(n) asm volatile("s_waitcnt vmcnt(" #n ")" ::: "memory")
#define PG8_WAIT_L(n) asm volatile("s_waitcnt lgkmcnt(" #n ")" ::: "memory")
#define PG8_BAR __builtin_amdgcn_s_barrier()
#define PG8_SCHED __builtin_amdgcn_sched_barrier(0)
    Unit cur, nxt; int ui = 0;
    if (!S.next(0, cur)) return;
    f32x4 acc[2][2][4][2];
#pragma unroll
    for (int a = 0; a < 2; ++a)
#pragma unroll
        for (int b = 0; b < 2; ++b)
#pragma unroll
            for (int m = 0; m < 4; ++m)
#pragma unroll
                for (int n = 0; n < 2; ++n) acc[a][b][m][n] = (f32x4){0.f, 0.f, 0.f, 0.f};
    bf16x8 At[4][2], B0[2][2], B1[2][2];
    const char* cA = (const char*)g.A + (size_t)cur.pm * tstep; const char* cB = (const char*)g.Bt + (size_t)cur.pn * tstep;
    S.a_ready(cur);
    if constexpr (SP2) {
        PG8_STAGE(PG8_SB(0, 0), cB, voffB); PG8_STAGE(PG8_SB(0, 1), cB + hstep, voffB); PG8_STAGE(PG8_SA(0, 0), cA, voffA); PG8_STAGE(PG8_SA(0, 1), cA + hstep, voffA);
        if (wr == 1) PG8_BAR;
        PG8_WAIT_V(2); PG8_BAR;
        PG8_STAGE(PG8_SB(1, 0), cB + kstep, voffB); PG8_STAGE(PG8_SA(1, 0), cA + kstep, voffA); PG8_STAGE(PG8_SB(1, 1), cB + hstep + kstep, voffB);
        PG8_WAIT_V(6); PG8_BAR;
    } else {
        PG8_STAGE(PG8_SB(0, 0), cB, voffB); PG8_STAGE(PG8_SA(0, 0), cA, voffA); PG8_STAGE(PG8_SB(0, 1), cB + hstep, voffB); PG8_STAGE(PG8_SA(0, 1), cA + hstep, voffA);
        if (wr == 1) PG8_BAR;
        PG8_WAIT_V(4); PG8_BAR;
        PG8_STAGE(PG8_SB(1, 0), cB + kstep, voffB); PG8_STAGE(PG8_SA(1, 0), cA + kstep, voffA); PG8_STAGE(PG8_SB(1, 1), cB + hstep + kstep, voffB);
        PG8_WAIT_V(6); PG8_BAR;
    }
    for (;;) {
        const bool has_next = S.next(ui + 1, nxt);
        const char* nA = has_next ? (const char*)g.A + (size_t)nxt.pm * tstep : cA; const char* nB = has_next ? (const char*)g.Bt + (size_t)nxt.pn * tstep : cB;
        for (int t = 0; t < nt; t += 2) {
            const bool last = (t == nt - 2);
            const char* a1 = cA + (size_t)(t + 1) * kstep;
            const char* a2 = last ? nA : cA + (size_t)(t + 2) * kstep; const char* b2 = last ? nB : cB + (size_t)(t + 2) * kstep;
            const char* a3 = a2 + kstep; const char* b3 = b2 + kstep;
            if (last && has_next) S.a_ready(nxt);
            if constexpr (SP2) {
            PG8_LDB(B0, 0, 0); PG8_LDB(B1, 0, 1); PG8_SCHED; PG8_LDA(At, 0, 0); PG8_STAGE(PG8_SA(1, 1), a1 + hstep, voffA);
            PG8_WAIT_V(8); PG8_WAIT_L(0); PG8_BAR; PG8_MMA(0, 0, At, B0); PG8_MMA(0, 1, At, B1); PG8_BAR; PG8_SCHED;
            PG8_LDA(At, 0, 1); PG8_STAGE(PG8_SB(0, 0), b2, voffB); PG8_STAGE(PG8_SB(0, 1), b2 + hstep, voffB); PG8_STAGE(PG8_SA(0, 0), a2, voffA);
            PG8_WAIT_V(8); PG8_WAIT_L(0); PG8_BAR; PG8_MMA(1, 0, At, B0); PG8_MMA(1, 1, At, B1); PG8_BAR; PG8_SCHED;
            PG8_LDB(B0, 1, 0); PG8_LDB(B1, 1, 1); PG8_SCHED; PG8_LDA(At, 1, 0); PG8_STAGE(PG8_SA(0, 1), a2 + hstep, voffA);
            PG8_WAIT_V(8); PG8_WAIT_L(0); PG8_BAR; PG8_MMA(0, 0, At, B0); PG8_MMA(0, 1, At, B1); PG8_BAR; PG8_SCHED;
            PG8_LDA(At, 1, 1); PG8_STAGE(PG8_SB(1, 0), b3, voffB); PG8_STAGE(PG8_SB(1, 1), b3 + hstep, voffB); PG8_STAGE(PG8_SA(1, 0), a3, voffA);
            PG8_WAIT_V(8); PG8_WAIT_L(0); PG8_BAR; PG8_MMA(1, 0, At, B0); PG8_MMA(1, 1, At, B1); PG8_BAR; PG8_SCHED;
            } else {
            PG8_LDB(B0, 0, 0); PG8_SCHED; PG8_LDA(At, 0, 0); PG8_STAGE(PG8_SA(1, 1), a1 + hstep, voffA);
            PG8_WAIT_L(8); PG8_BAR; PG8_WAIT_L(0); PG8_MMA(0, 0, At, B0); PG8_BAR; PG8_SCHED;
            PG8_LDB(B1, 0, 1); PG8_STAGE(PG8_SB(0, 0), b2, voffB);
            PG8_BAR; PG8_WAIT_L(0); PG8_MMA(0, 1, At, B1); PG8_BAR;
            PG8_LDA(At, 0, 1); PG8_STAGE(PG8_SA(0, 0), a2, voffA);
            PG8_BAR; PG8_WAIT_L(0); PG8_MMA(1, 0, At, B0); PG8_BAR; PG8_SCHED;
            PG8_STAGE(PG8_SB(0, 1), b2 + hstep, voffB);
            PG8_WAIT_V(6); PG8_BAR; PG8_MMA(1, 1, At, B1); PG8_BAR;
            PG8_LDB(B0, 1, 0); PG8_SCHED; PG8_LDA(At, 1, 0); PG8_STAGE(PG8_SA(0, 1), a2 + hstep, voffA);
            PG8_WAIT_L(8); PG8_BAR; PG8_WAIT_L(0); PG8_MMA(0, 0, At, B0); PG8_BAR; PG8_SCHED;
            PG8_LDB(B1, 1, 1); PG8_STAGE(PG8_SB(1, 0), b3, voffB);
            PG8_BAR; PG8_WAIT_L(0); PG8_MMA(0, 1, At, B1); PG8_BAR;
            PG8_LDA(At, 1, 1); PG8_STAGE(PG8_SA(1, 0), a3, voffA);
            PG8_BAR; PG8_WAIT_L(0); PG8_MMA(1, 0, At, B0); PG8_BAR; PG8_SCHED;
            PG8_STAGE(PG8_SB(1, 1), b3 + hstep, voffB);
            PG8_WAIT_V(6); PG8_BAR; PG8_MMA(1, 1, At, B1); PG8_BAR;
            }
        }
        if constexpr (ALIGN_EPI) { if (wr == 0) PG8_BAR; }
        if constexpr (!Epi::AFTER_DRAIN) { E(acc, cur, wr, wc, fr, fq); S.done(cur); }
        if (!has_next) break;
#pragma unroll
        for (int a = 0; a < 2; ++a)
#pragma unroll
            for (int b = 0; b < 2; ++b)
#pragma unroll
                for (int m = 0; m < 4; ++m)
#pragma unroll
                    for (int n = 0; n < 2; ++n) acc[a][b][m][n] = (f32x4){0.f, 0.f, 0.f, 0.f};
        cur = nxt; cA = nA; cB = nB; ++ui;
        if constexpr (ALIGN_EPI) { if (wr == 1) PG8_BAR; }
    }
    PG8_WAIT_V(0);
    if constexpr (!ALIGN_EPI) { if (wr == 0) PG8_BAR; }
    PG8_BAR;
    if constexpr (Epi::AFTER_DRAIN) { E.fused(acc, cur, wr, wc, fr, fq, lds, wid, lane); S.done(cur); }
#undef PG8_SA
#undef PG8_SB
#undef PG8_STAGE
#undef PG8_LDA
#undef PG8_LDB
#undef PG8_MMA
#undef PG8_WAIT_V
#undef PG8_WAIT_L
#undef PG8_BAR
#undef PG8_SCHED
}
}

#ifndef N_LAUNCHES
#define N_LAUNCHES 1
#endif
constexpr int D = 1024, NB = 8, SEQ = 4096, DB = 8, DS = 32, PAST = 1024, NMETA = 16, NH = 4;
constexpr int MFR = NB * SEQ;
constexpr int MDR = DB * DS;
constexpr int R_DEC = MFR, R_META = MFR + MDR, R_ALL = R_META + NMETA;
constexpr int KVP = NMETA + SEQ;
constexpr int KVD = NMETA + PAST + DS;
constexpr int WIN = 4096;
constexpr float EPS = 1e-6f;
constexpr float LOG2E = 1.4426950408889634f;
constexpr float QSCALE = 0.125f * LOG2E;
constexpr float LAM_INIT = 0.2f;
constexpr size_t O_YP = 0, O_YS = 33554432, O_KP = 33816576, O_VP = 50659328, O_CP = 67502080, O_KS = 67510272, O_VS = 67641344, O_CS = 67772416, O_END = 67780608;
constexpr size_t MiB = 1u << 20;
constexpr size_t WS_PART = 1 * MiB;
constexpr size_t WS_PARTD = 3 * MiB;
constexpr size_t WS_WIN = 4 * MiB;
constexpr size_t WS_WOUT = 12 * MiB;
constexpr size_t WS_XN = 16 * MiB;
constexpr size_t WS_Q = 96 * MiB;
constexpr size_t WS_ZA = 132 * MiB;
constexpr size_t WS_G = 168 * MiB;
constexpr size_t WS_K = 204 * MiB;
constexpr size_t WS_V = 240 * MiB;
constexpr size_t WS_CU = 276 * MiB;
constexpr size_t WS_KD = 312 * MiB;
constexpr size_t WS_VD = 324 * MiB;
constexpr size_t WS_CUD = 336 * MiB;
constexpr size_t WS_M = 340 * MiB;
constexpr size_t WS_END = 408 * MiB;

constexpr int LDS_BYTES = 147456;
constexpr int NWAVES = 8;

#define LAS __attribute__((address_space(3)))
typedef unsigned short bf16;
typedef unsigned u32x4 __attribute__((ext_vector_type(4)));
typedef unsigned u32x2 __attribute__((ext_vector_type(2)));
typedef float f32x4 __attribute__((ext_vector_type(4)));
typedef float f32x2 __attribute__((ext_vector_type(2)));
typedef float f32x16 __attribute__((ext_vector_type(16)));
typedef short bf16x8 __attribute__((ext_vector_type(8)));
typedef short s16x4 __attribute__((ext_vector_type(4)));
typedef __bf16 bf16x2_t __attribute__((ext_vector_type(2)));

__device__ __forceinline__ unsigned pk2(float lo, float hi) { f32x2 v = {lo, hi}; bf16x2_t b = __builtin_convertvector(v, bf16x2_t); return __builtin_bit_cast(unsigned, b); }
__device__ __forceinline__ bf16 f2bf(float f) { return (bf16)(pk2(f, 0.f) & 0xffffu); }
__device__ __forceinline__ float bf2f(unsigned short b) { return __builtin_bit_cast(float, ((unsigned)b) << 16); }
__device__ __forceinline__ float bflo(unsigned w) { return __builtin_bit_cast(float, w << 16); }
__device__ __forceinline__ float bfhi(unsigned w) { return __builtin_bit_cast(float, w & 0xffff0000u); }
__device__ __forceinline__ float ex2(float x) { return __builtin_amdgcn_exp2f(x); }
__device__ __forceinline__ float silu(float x) { return x * __builtin_amdgcn_rcpf(1.0f + ex2(-x * LOG2E)); }
__device__ __forceinline__ float wave_sum(float v) {
#pragma unroll
    for (int o = 1; o < 64; o <<= 1) v += __shfl_xor(v, o);
    return v;
}
__device__ __forceinline__ float swap32f(float v) { return __shfl_xor(v, 32); }
#define LDS_WAIT() asm volatile("s_waitcnt lgkmcnt(0)" ::: "memory")

struct Ptrs {
    const float *xp, *xs, *ck, *cv, *sc, *meta, *relb, *ng, *win, *cw, *lq1, *lk1, *lq2, *lk2, *sg, *wout, *fg;
    float* out;
    bf16 *WtIn, *WtOut, *XN, *Qb, *ZA, *Gb, *Kb, *Vb, *CUb, *KbD, *VbD, *CUd, *Mb;
    float *part, *partD;
};

__device__ __forceinline__ int win_src_col(int n) {
    if (n < 2048) return n;
    if (n < 3072) { const int u = (n - 2048) >> 8, w = (n - 2048) & 255; return w < 128 ? 2048 + 128 * u + w : 3584 + 128 * u + (w - 128); }
    const int u = (n - 3072) >> 8, w = (n - 3072) & 255; return w < 128 ? 2560 + 128 * u + w : 3072 + 128 * u + (w - 128);
}
__device__ __forceinline__ void p0_transpose_item(const float* W, int N, int K, bf16* WT, int n_src0, int n_dst0, int k0, LAS float* scr, int lane) {
#pragma unroll 8
    for (int i = 0; i < 32; ++i) { const int kk = 2 * i + (lane >> 5); scr[kk * 33 + (lane & 31)] = W[(size_t)(k0 + kk) * N + n_src0 + (lane & 31)]; }
    LDS_WAIT(); asm volatile("" ::: "memory");
    const int c = lane & 7;
#pragma unroll
    for (int j = 0; j < 4; ++j) { const int n = (lane >> 3) + 8 * j; const LAS float* s = scr + (8 * c) * 33 + n;
        u32x4 o; o.x = pk2(s[0 * 33], s[1 * 33]); o.y = pk2(s[2 * 33], s[3 * 33]); o.z = pk2(s[4 * 33], s[5 * 33]); o.w = pk2(s[6 * 33], s[7 * 33]);
        *(u32x4*)(WT + (size_t)(n_dst0 + n) * K + k0 + 8 * c) = o; }
    LDS_WAIT(); asm volatile("" ::: "memory");
}
__device__ __forceinline__ void rms_row_to_bf16(const float* xrow, const float* g, bf16* orow, int lane) {
    const f32x4* xr = (const f32x4*)xrow + lane; const f32x4* gr = (const f32x4*)g + lane;
    f32x4 v[4]; float s = 0.f;
#pragma unroll
    for (int j = 0; j < 4; ++j) { v[j] = xr[64 * j]; s += (v[j].x * v[j].x + v[j].y * v[j].y) + (v[j].z * v[j].z + v[j].w * v[j].w); }
    const float rstd = 1.0f / sqrtf(wave_sum(s) * (1.f / D) + EPS);
    u32x2* o8 = (u32x2*)orow + lane;
#pragma unroll
    for (int j = 0; j < 4; ++j) { const f32x4 gg = gr[64 * j]; u32x2 o; o.x = pk2(v[j].x * rstd * gg.x, v[j].y * rstd * gg.y); o.y = pk2(v[j].z * rstd * gg.z, v[j].w * rstd * gg.w); o8[64 * j] = o; }
}
__device__ __forceinline__ void p0_prologue(const Ptrs& P, LAS unsigned char* lds, int vcu, int G, int wave, int lane) {
    LAS float* scr = (LAS float*)(lds + wave * 16384);
    const int gw = vcu * NWAVES + wave, NGW = G * NWAVES;
    constexpr int I_IN = (D / 64) * (WIN / 32), I_OUT = (D / 64) * (D / 32);
    for (int it = gw; it < I_IN + I_OUT; it += NGW) {
        if (it < I_IN) { const int kb = it / (WIN / 32), nb = it % (WIN / 32); p0_transpose_item(P.win, WIN, D, P.WtIn, win_src_col(32 * nb), 32 * nb, 64 * kb, scr, lane); }
        else { const int r = it - I_IN, kb = r / (D / 32), nb = r % (D / 32); p0_transpose_item(P.wout, D, D, P.WtOut, 32 * nb, 32 * nb, 64 * kb, scr, lane); }
    }
    for (int R = gw; R < R_ALL; R += NGW) {
        const float* xr = R < R_DEC ? P.xp + (size_t)R * D : (R < R_META ? P.xs + (size_t)(R - R_DEC) * D : P.meta + (size_t)(R - R_META) * D);
        rms_row_to_bf16(xr, P.ng, P.XN + (size_t)R * D, lane);
    }
    constexpr int CROWS = DB * (NMETA + PAST);
    for (int it = gw; it < 2 * CROWS; it += NGW) {
        const int isv = it >= CROWS, r = isv ? it - CROWS : it, b = r / (NMETA + PAST), j = r % (NMETA + PAST);
        const float* src = (isv ? P.cv : P.ck) + (size_t)r * 512 + lane * 8;
        bf16* dst = (isv ? P.VbD : P.KbD) + ((size_t)b * KVD + j) * 512 + lane * 8;
        const f32x4 a = *(const f32x4*)src, c = *(const f32x4*)(src + 4);
        u32x4 o; o.x = pk2(a.x, a.y); o.y = pk2(a.z, a.w); o.z = pk2(c.x, c.y); o.w = pk2(c.z, c.w);
        *(u32x4*)dst = o;
    }
}

__device__ __forceinline__ u32x4 pack8(const f32x4 a, const f32x4 b) { u32x4 w; w.x = pk2(a.x, a.y); w.y = pk2(a.z, a.w); w.z = pk2(b.x, b.y); w.w = pk2(b.z, b.w); return w; }
__device__ __forceinline__ f32x4 silu4(const f32x4 a) { return (f32x4){silu(a.x), silu(a.y), silu(a.z), silu(a.w)}; }
struct EpiIn {
    static constexpr bool PERM = true, AFTER_DRAIN = false;
    bf16 *Qb, *ZA, *Gb, *Kb, *Vb, *CUb; float* out;
    __device__ __forceinline__ void operator()(const f32x4 (&acc)[2][2][4][2], const pg8::Unit& u, int wr, int wc, int fr, int fq) const {
        const int typ = u.pn >> 1;
        const int b = u.pm >> 4, t0 = (u.pm & 15) * 256 + wr * 64 + fr;
        const size_t rowA0 = (size_t)u.pm * 256 + wr * 64 + fr, kvrow0 = (size_t)b * KVP + NMETA + t0;
        if (typ == 0) {
            const int col = (u.pn & 1) * 256 + wc * 32 + 8 * fq;
#pragma unroll
            for (int ai = 0; ai < 2; ++ai)
#pragma unroll
                for (int m = 0; m < 4; ++m) { bf16* rp = Qb + (rowA0 + ai * 128 + m * 16) * 512 + col;
#pragma unroll
                    for (int bj = 0; bj < 2; ++bj) *(u32x4*)(rp + bj * 128) = pack8(acc[ai][bj][m][0] * QSCALE, acc[ai][bj][m][1] * QSCALE); }
        } else if (typ == 1 || typ == 2) {
            const int col = (u.pn & 1) * 256 + wc * 32 + 8 * fq;
            float* o = out + (typ == 1 ? O_KP : O_VP); bf16* kb = typ == 1 ? Kb : Vb;
#pragma unroll
            for (int ai = 0; ai < 2; ++ai)
#pragma unroll
                for (int m = 0; m < 4; ++m) { const size_t off = (kvrow0 + ai * 128 + m * 16) * 512 + col;
#pragma unroll
                    for (int bj = 0; bj < 2; ++bj) { *(f32x4*)(o + off + bj * 128) = acc[ai][bj][m][0]; *(f32x4*)(o + off + bj * 128 + 4) = acc[ai][bj][m][1];
                        *(u32x4*)(kb + off + bj * 128) = pack8(acc[ai][bj][m][0], acc[ai][bj][m][1]); } }
        } else if (typ == 3) {
            const int col = (u.pn & 1) * 256 + wc * 32 + 8 * fq;
#pragma unroll
            for (int ai = 0; ai < 2; ++ai)
#pragma unroll
                for (int m = 0; m < 4; ++m) { bf16* rp = ZA + (rowA0 + ai * 128 + m * 16) * 512 + col;
#pragma unroll
                    for (int bj = 0; bj < 2; ++bj) *(u32x4*)(rp + bj * 128) = pack8(silu4(acc[ai][bj][m][0]), silu4(acc[ai][bj][m][1])); }
        } else if (typ < 6) {
            const int col = (u.pn - 8) * 128 + wc * 32 + 8 * fq;
#pragma unroll
            for (int ai = 0; ai < 2; ++ai)
#pragma unroll
                for (int m = 0; m < 4; ++m)
                    *(u32x4*)(Gb + (rowA0 + ai * 128 + m * 16) * 512 + col) = pack8(silu4(acc[ai][1][m][0]) * acc[ai][0][m][0], silu4(acc[ai][1][m][1]) * acc[ai][0][m][1]);
        } else {
            const int col = (u.pn - 12) * 128 + wc * 32 + 8 * fq;
#pragma unroll
            for (int ai = 0; ai < 2; ++ai)
#pragma unroll
                for (int m = 0; m < 4; ++m) { const f32x4 c0 = acc[ai][0][m][0] * acc[ai][1][m][0], c1 = acc[ai][0][m][1] * acc[ai][1][m][1];
                    *(u32x4*)(CUb + (kvrow0 + ai * 128 + m * 16) * 512 + col) = pack8(c0, c1);
                    const int t = t0 + ai * 128 + m * 16;
                    if (t >= SEQ - 2) { float* cp = out + O_CP + ((size_t)b * 2 + (t - (SEQ - 2))) * 512 + col; *(f32x4*)cp = c0; *(f32x4*)(cp + 4) = c1; } }
        }
    }
};
struct EpiOut {
    static constexpr bool PERM = true, AFTER_DRAIN = false;
    const float* x; float* y; float* part;
    __device__ __forceinline__ void operator()(const f32x4 (&acc)[2][2][4][2], const pg8::Unit& u, int wr, int wc, int fr, int fq) const {
        const size_t row0 = (size_t)u.pm * 256 + wr * 64 + fr; const int col = u.pn * 256 + wc * 32 + 8 * fq;
#pragma unroll
        for (int ai = 0; ai < 2; ++ai)
#pragma unroll
            for (int m = 0; m < 4; ++m) { const size_t row = row0 + ai * 128 + m * 16, off = row * D + col; float ss = 0.f;
#pragma unroll
                for (int bj = 0; bj < 2; ++bj) {
                    const f32x4 h0 = *(const f32x4*)(x + off + bj * 128) + acc[ai][bj][m][0], h1 = *(const f32x4*)(x + off + bj * 128 + 4) + acc[ai][bj][m][1];
                    *(f32x4*)(y + off + bj * 128) = h0; *(f32x4*)(y + off + bj * 128 + 4) = h1;
                    ss += (h0.x * h0.x + h0.y * h0.y) + (h0.z * h0.z + h0.w * h0.w) + (h1.x * h1.x + h1.y * h1.y) + (h1.z * h1.z + h1.w * h1.w); }
                ss += __shfl_xor(ss, 16); ss += __shfl_xor(ss, 32);
                if (fq == 0) part[row * 16 + u.pn * 4 + wc] = ss; }
    }
};

template <int MFN>
__device__ __forceinline__ void small_mma_stage(const bf16* A, const bf16* Bt, int brow, LAS unsigned char* lds, int wave, int lane) {
    const int col = lane & 15, kq = lane >> 4;
    const bf16* bp = Bt + (size_t)brow * D + 128 * wave + 8 * kq;
    bf16x8 bfrag[4];
#pragma unroll
    for (int ks = 0; ks < 4; ++ks) bfrag[ks] = *(const bf16x8*)(bp + 32 * ks);
    __syncthreads();
    const bf16* ap = A + (size_t)col * D + 128 * wave + 8 * kq;
#pragma unroll 2
    for (int mf = 0; mf < MFN; ++mf) {
        f32x4 acc = (f32x4){0.f, 0.f, 0.f, 0.f};
#pragma unroll
        for (int ks = 0; ks < 4; ++ks) acc = __builtin_amdgcn_mfma_f32_16x16x32_bf16(*(const bf16x8*)(ap + (size_t)mf * 16 * D + 32 * ks), bfrag[ks], acc, 0, 0, 0);
        *(LAS f32x4*)(lds + ((wave * MFN + mf) * 64 + lane) * 16) = acc;
    }
    __syncthreads();
}
template <int MFN>
__device__ __forceinline__ f32x4 small_reduce(LAS unsigned char* lds, int mf, int lane) {
    f32x4 s = (f32x4){0.f, 0.f, 0.f, 0.f};
#pragma unroll
    for (int w = 0; w < 8; ++w) s += *(const LAS f32x4*)(lds + ((w * MFN + mf) * 64 + lane) * 16);
    return s;
}
__device__ __forceinline__ void small_in_tile(const Ptrs& P, LAS unsigned char* lds, int j, int wave, int lane) {
    const int col = lane & 15;
    int np;
    if (j < 128) np = 16 * j + col; else { const int jj = j - 128; np = 2048 + 256 * (jj >> 4) + 8 * (jj & 15) + (col & 7) + 128 * (col >> 3); }
    small_mma_stage<17>(P.XN + (size_t)R_DEC * D, P.WtIn, np, lds, wave, lane);
#pragma unroll 1
    for (int mf = wave; mf < 17; mf += 8) {
        const f32x4 res = small_reduce<17>(lds, mf, lane);
#pragma unroll
        for (int i = 0; i < 4; ++i) {
            const float v = res[i]; const float other = __shfl_xor(v, 8);
            const int rr = 16 * mf + 4 * (lane >> 4) + i;
            if (mf < 16) {
                const int b = rr >> 5, t = rr & 31; const size_t R = (size_t)R_DEC + rr;
                if (j < 128) { const int typ = np >> 9, cc = np & 511;
                    if (typ == 0) P.Qb[R * 512 + cc] = f2bf(v * QSCALE);
                    else if (typ == 1) { P.out[O_KS + (size_t)rr * 512 + cc] = v; P.KbD[((size_t)b * KVD + NMETA + PAST + t) * 512 + cc] = f2bf(v); }
                    else if (typ == 2) { P.out[O_VS + (size_t)rr * 512 + cc] = v; P.VbD[((size_t)b * KVD + NMETA + PAST + t) * 512 + cc] = f2bf(v); }
                    else P.ZA[R * 512 + cc] = f2bf(silu(v));
                } else if (col < 8) { const int jq = j - 128, u8 = jq >> 4, c = 128 * (u8 & 3) + 8 * (jq & 15) + col;
                    if (u8 < 4) P.Gb[R * 512 + c] = f2bf(silu(other) * v);
                    else { const float cu = v * other; P.CUd[(size_t)rr * 512 + c] = f2bf(cu); if (t >= DS - 2) P.out[O_CS + ((size_t)b * 2 + (t - (DS - 2))) * 512 + c] = cu; }
                }
            } else {
                const int m = rr - 256;
                if (j < 128) { const int typ = np >> 9, cc = np & 511;
                    if (typ == 1 || typ == 2) { float* o = P.out + (typ == 1 ? O_KP : O_VP); bf16* kb = typ == 1 ? P.Kb : P.Vb; const bf16 vb = f2bf(v);
                        for (int b = 0; b < NB; ++b) { const size_t off = ((size_t)b * KVP + m) * 512 + cc; o[off] = v; kb[off] = vb; } }
                } else if (col < 8) { const int jq = j - 128, u8 = jq >> 4, c = 128 * (u8 & 3) + 8 * (jq & 15) + col;
                    if (u8 >= 4) { const bf16 cb = f2bf(v * other); for (int b = 0; b < NB; ++b) P.CUb[((size_t)b * KVP + m) * 512 + c] = cb; } }
            }
        }
    }
}
__device__ __forceinline__ void small_out_tile(const Ptrs& P, LAS unsigned char* lds, int j, int wave, int lane) {
    const int rg = j >> 6, cg_ = j & 63, col = lane & 15, n = 16 * cg_ + col;
    small_mma_stage<4>(P.Mb + (size_t)(R_DEC + 64 * rg) * D, P.WtOut, n, lds, wave, lane);
    if (wave < 4) {
        const f32x4 res = small_reduce<4>(lds, wave, lane);
#pragma unroll
        for (int i = 0; i < 4; ++i) { const int r = 64 * rg + 16 * wave + 4 * (lane >> 4) + i;
            const float h = P.xs[(size_t)r * D + n] + res[i]; P.out[O_YS + (size_t)r * D + n] = h;
            float ss = h * h; ss += __shfl_xor(ss, 1); ss += __shfl_xor(ss, 2); ss += __shfl_xor(ss, 4); ss += __shfl_xor(ss, 8);
            if (col == 0) P.partD[r * 64 + cg_] = ss; }
    }
}

constexpr int AT_SLOT = 32768, AT_V = 16384, AT_LUT = 98304, AT_Q = 102400, AT_XCH = 0;
constexpr float AT_THR = 8.0f;
__device__ __forceinline__ int crow(int r, int hi) { return (r & 3) + 8 * (r >> 2) + 4 * hi; }
__device__ __forceinline__ int rel_bucket(int rel) {
    const int n = rel < 0 ? -rel : rel; int v;
    if (n < 8) v = n; else if (n < 12) v = 8; else if (n < 16) v = 9; else if (n < 23) v = 10; else if (n < 32) v = 11; else if (n < 46) v = 12; else if (n < 64) v = 13; else if (n < 91) v = 14; else v = 15;
    return (rel > 0 ? 16 : 0) + v;
}
__device__ __forceinline__ s16x4 vtr(const LAS unsigned char* p) { return __builtin_bit_cast(s16x4, __builtin_amdgcn_ds_read_tr16_b64_v4i16((LAS s16x4*)p)); }
__device__ __forceinline__ float max3f(float a, float b, float c) { float r; asm("v_max3_f32 %0, %1, %2, %3" : "=v"(r) : "v"(a), "v"(b), "v"(c)); return r; }
__device__ __forceinline__ float xhalf_max(float m) { return fmaxf(m, __shfl_xor(m, 32)); }
__device__ __forceinline__ float xhalf_sum(float m) { return m + __shfl_xor(m, 32); }

__device__ __forceinline__ void attn_unit(const bool DEC, const Ptrs& P, LAS unsigned char* lds, int b, int h, int qb, float lam, int wave, int lane) {
    const int g = wave >> 1, c = wave & 1, r32 = lane & 31, hi = lane >> 5;
    const int qpos0 = DEC ? PAST : 128 * qb + 32 * g;
    const size_t R0 = DEC ? (size_t)R_DEC + b * DS : (size_t)b * SEQ + qpos0;
    const bool active = DEC ? (g == 0) : true;
    const bf16* Kg = (DEC ? P.KbD + (size_t)b * KVD * 512 : P.Kb + (size_t)b * KVP * 512) + h * 128;
    const bf16* Vg = (DEC ? P.VbD + (size_t)b * KVD * 512 : P.Vb + (size_t)b * KVP * 512) + h * 128;
    const int NT = DEC ? 18 : 2 * qb + 3;
    const int my_last = active ? (DEC ? 17 : 1 + (qpos0 >> 6)) : -1;
    LAS unsigned char* qlds = lds + AT_Q + wave * 4096 + lane * 16;
    { const bf16* qp = P.Qb + (R0 + r32) * 512 + h * 128 + c * 64 + 8 * hi;
#pragma unroll
      for (int ks = 0; ks < 4; ++ks) *(LAS bf16x8*)(qlds + 1024 * ks) = *(const bf16x8*)(qp + 16 * ks); }
    const unsigned kso = (unsigned)((16 * (wave >> 2) + (lane & 15)) * 512 + (4 * (wave & 3) + (lane >> 4)) * 8);
    const unsigned vso = (unsigned)((4 * wave + ((lane >> 1) & 3)) * 512 + (lane >> 3) * 16 + (lane & 1) * 8);
    LAS unsigned char* dmadst = lds + wave * 1024;
#define AT_SYNC() do { asm volatile("s_waitcnt vmcnt(0)" ::: "memory"); __syncthreads(); } while (0)
#define AT_ROWOFF(t) ((t) == 0 ? 0 : NMETA + 64 * ((t) - 1))
#define AT_DMA(t, slot) do { const bf16* kt_ = Kg + (size_t)AT_ROWOFF(t) * 512; const bf16* vt_ = Vg + (size_t)AT_ROWOFF(t) * 512; LAS unsigned char* d_ = dmadst + (slot) * AT_SLOT; \
        __builtin_amdgcn_global_load_lds((const unsigned*)(kt_ + kso), (LAS unsigned*)(d_), 16, 0, 0); \
        __builtin_amdgcn_global_load_lds((const unsigned*)(kt_ + 32 * 512 + kso), (LAS unsigned*)(d_ + 8192), 16, 0, 0); \
        __builtin_amdgcn_global_load_lds((const unsigned*)(vt_ + vso), (LAS unsigned*)(d_ + AT_V), 16, 0, 0); \
        __builtin_amdgcn_global_load_lds((const unsigned*)(vt_ + 32 * 512 + vso), (LAS unsigned*)(d_ + AT_V + 8192), 16, 0, 0); } while (0)
    const unsigned kofs = (unsigned)((r32 >> 4) * 4096 + (c * 8 + hi) * 256 + (r32 & 15) * 16);
    const unsigned vofs = (unsigned)(AT_V + hi * 1024 + ((lane >> 4) & 1) * 128 + ((lane & 15) >> 2) * 32 + (lane & 3) * 8);
    const LAS float* lut = (const LAS float*)(lds + AT_LUT) + h * 256;

    f32x16 O[4];
#pragma unroll
    for (int dg = 0; dg < 4; ++dg)
#pragma unroll
        for (int r = 0; r < 16; ++r) O[dg][r] = 0.f;
    f32x16 negm;
#pragma unroll
    for (int r = 0; r < 16; ++r) negm[r] = 0.f;
    float m_used = 0.f, l_run = 0.f;

#define AT_QK(S0, S1, tt, slot, FAST) do { \
        const int nv_ = (FAST) ? 64 : ((tt) == 0 ? 16 : ((DEC && (tt) == 17) ? 32 : 64)); const int kp_ = (tt) == 0 ? -NMETA : 64 * ((tt) - 1); \
        const LAS unsigned char* kb_ = lds + (slot) * AT_SLOT; \
        if (!(FAST) && kp_ + nv_ - 1 - qpos0 >= -90) { const LAS float* lp_ = lut + (kp_ - qpos0 - r32 + 4 * hi + 192); \
            _Pragma("unroll") for (int r = 0; r < 16; ++r) { S0[r] = lp_[(r & 3) + 8 * (r >> 2)] + negm[r]; S1[r] = lp_[32 + (r & 3) + 8 * (r >> 2)] + negm[r]; } \
        } else { S0 = negm; S1 = negm; } \
        _Pragma("unroll") for (int ks = 0; ks < 4; ++ks) { \
            const bf16x8 qf_ = *(const LAS bf16x8*)(qlds + 1024 * ks); \
            S0 = __builtin_amdgcn_mfma_f32_32x32x16_bf16(*(const LAS bf16x8*)(kb_ + kofs + 512 * ks), qf_, S0, 0, 0, 0); \
            if (nv_ > 32) S1 = __builtin_amdgcn_mfma_f32_32x32x16_bf16(*(const LAS bf16x8*)(kb_ + kofs + 512 * ks + 8192), qf_, S1, 0, 0, 0); } \
        if (nv_ == 16) { _Pragma("unroll") for (int r = 8; r < 16; ++r) S0[r] = -INFINITY; } \
        if (nv_ <= 32) { _Pragma("unroll") for (int r = 0; r < 16; ++r) S1[r] = -INFINITY; } \
    } while (0)
#define AT_MAXCHECK(S0, S1, first) do { \
        asm volatile("s_nop 15\n\ts_nop 7" : "+v"(S0), "+v"(S1));     \
        float mx_ = max3f(S0[0], S0[1], S1[0]); mx_ = max3f(mx_, S1[1], S0[2]); mx_ = max3f(mx_, S0[3], S1[2]); mx_ = fmaxf(mx_, S1[3]); \
        _Pragma("unroll") for (int r = 4; r < 16; r += 4) { mx_ = max3f(mx_, S0[r], S0[r + 1]); mx_ = max3f(mx_, S0[r + 2], S0[r + 3]); mx_ = max3f(mx_, S1[r], S1[r + 1]); mx_ = max3f(mx_, S1[r + 2], S1[r + 3]); } \
        mx_ = xhalf_max(mx_); \
        if ((first) || __any(mx_ > AT_THR)) { \
            const float dl_ = (first) ? mx_ : fmaxf(mx_, 0.f); \
            if (!(first)) { const float al_ = ex2(-dl_); l_run *= al_; \
                _Pragma("unroll") for (int dg = 0; dg < 4; ++dg) _Pragma("unroll") for (int r = 0; r < 16; ++r) O[dg][r] *= al_; } \
            _Pragma("unroll") for (int r = 0; r < 16; ++r) { S0[r] -= dl_; S1[r] -= dl_; } \
            m_used += dl_; \
            _Pragma("unroll") for (int r = 0; r < 16; ++r) negm[r] = -m_used; \
        } } while (0)
#define AT_SMPV(S0, S1, tt, slot, FAST) do { \
        const int nv_ = (FAST) ? 64 : ((tt) == 0 ? 16 : ((DEC && (tt) == 17) ? 32 : 64)); \
        const LAS unsigned char* vb_ = lds + (slot) * AT_SLOT; \
        float ls_ = 0.f; \
        _Pragma("unroll") for (int r = 0; r < 16; ++r) { S0[r] = ex2(S0[r]); S1[r] = ex2(S1[r]); ls_ += S0[r] + S1[r]; } \
        l_run += ls_; \
        bf16x8 pf_[4]; \
        _Pragma("unroll") for (int k2 = 0; k2 < 2; ++k2) { u32x4 w0_, w1_; \
            w0_.x = pk2(S0[8 * k2 + 0], S0[8 * k2 + 1]); w0_.y = pk2(S0[8 * k2 + 2], S0[8 * k2 + 3]); w0_.z = pk2(S0[8 * k2 + 4], S0[8 * k2 + 5]); w0_.w = pk2(S0[8 * k2 + 6], S0[8 * k2 + 7]); \
            w1_.x = pk2(S1[8 * k2 + 0], S1[8 * k2 + 1]); w1_.y = pk2(S1[8 * k2 + 2], S1[8 * k2 + 3]); w1_.z = pk2(S1[8 * k2 + 4], S1[8 * k2 + 5]); w1_.w = pk2(S1[8 * k2 + 6], S1[8 * k2 + 7]); \
            pf_[k2] = __builtin_bit_cast(bf16x8, w0_); pf_[2 + k2] = __builtin_bit_cast(bf16x8, w1_); } \
        const int nks_ = nv_ >> 4; \
        _Pragma("unroll") for (int ks = 0; ks < 4; ++ks) { if (ks < nks_) { asm volatile("" ::: "memory"); \
            _Pragma("unroll") for (int dg = 0; dg < 4; ++dg) { \
                const s16x4 lo_ = vtr(vb_ + vofs + ks * 4096 + dg * 256), hh_ = vtr(vb_ + vofs + ks * 4096 + dg * 256 + 2048); \
                const bf16x8 vf_ = (bf16x8){lo_[0], lo_[1], lo_[2], lo_[3], hh_[0], hh_[1], hh_[2], hh_[3]}; \
                O[dg] = __builtin_amdgcn_mfma_f32_32x32x16_bf16(vf_, pf_[ks], O[dg], 0, 0, 0); } } } \
    } while (0)

    AT_DMA(0, 0); AT_DMA(1, 1);
    AT_SYNC();
    f32x16 sa0, sa1, sb0, sb1;
    if (active) AT_QK(sa0, sa1, 0, 0, false);
    int sl0 = 0, sl1 = 1, sl2 = 2;
#define AT_ROT() do { const int s_ = sl0; sl0 = sl1; sl1 = sl2; sl2 = s_; } while (0)
#define AT_STEP(SC0, SC1, SN0, SN1, FAST) do { \
        if (t + 2 < NT) AT_DMA(t + 2, sl2); \
        AT_MAXCHECK(SC0, SC1, (!(FAST) && t == 0)); \
        AT_QK(SN0, SN1, t + 1, sl1, FAST); \
        AT_SMPV(SC0, SC1, t, sl0, FAST); \
        AT_SYNC(); AT_ROT(); ++t; } while (0)
    int t = 0;
    const int tfe = active ? (qpos0 - 91) / 64 : 0;
    if (t < my_last) { AT_STEP(sa0, sa1, sb0, sb1, false); sa0 = sb0; sa1 = sb1; }
    while (t + 2 < tfe && t + 2 <= my_last) { AT_STEP(sa0, sa1, sb0, sb1, true); AT_STEP(sb0, sb1, sa0, sa1, true); }
    while (t < my_last) { AT_STEP(sa0, sa1, sb0, sb1, false); sa0 = sb0; sa1 = sb1; }
    if (active) {
        if (t + 2 < NT) AT_DMA(t + 2, sl2);
        AT_MAXCHECK(sa0, sa1, t == 0);
        AT_SMPV(sa0, sa1, t, sl0, false);
        AT_SYNC(); AT_ROT(); ++t;
    }
    for (; t < NT; ++t) {
        if (t + 2 < NT) AT_DMA(t + 2, sl2);
        AT_SYNC(); AT_ROT();
    }
#undef AT_STEP
#undef AT_ROT
#undef AT_SYNC
#undef AT_ROWOFF
#undef AT_DMA
#undef AT_QK
#undef AT_MAXCHECK
#undef AT_SMPV
    const float lt = xhalf_sum(l_run);
    const float sc = (c == 0 ? 1.0f : lam) / lt;
    LAS float* xch = (LAS float*)(lds + AT_XCH) + g * 4096 + lane;
    if (active && c == 1) {
#pragma unroll
        for (int dg = 0; dg < 4; ++dg)
#pragma unroll
            for (int r = 0; r < 16; ++r) xch[(dg * 16 + r) * 64] = O[dg][r] * sc;
    }
    __syncthreads();
    float ss = 0.f;
    if (active && c == 0) {
#pragma unroll
        for (int dg = 0; dg < 4; ++dg)
#pragma unroll
            for (int r = 0; r < 16; ++r) { const float o = O[dg][r] * sc - xch[(dg * 16 + r) * 64]; O[dg][r] = o; ss += o * o; }
    }
    __syncthreads();
    if (active && c == 0) {
        ss = xhalf_sum(ss);
        const float rs = (1.0f - LAM_INIT) / sqrtf(ss * (1.f / 128.f) + EPS);
        const size_t R = R0 + r32;
#pragma unroll
        for (int dg = 0; dg < 4; ++dg)
#pragma unroll
            for (int k = 0; k < 4; ++k) {
                const int dv0 = 32 * dg + 8 * k + 4 * hi;
                const f32x4 gg = *(const f32x4*)(P.sg + dv0);
                const u32x2 za = *(const u32x2*)(P.ZA + R * 512 + h * 128 + dv0);
                u32x2 w;
                w.x = pk2(O[dg][4 * k + 0] * rs * gg.x * bflo(za.x), O[dg][4 * k + 1] * rs * gg.y * bfhi(za.x));
                w.y = pk2(O[dg][4 * k + 2] * rs * gg.z * bflo(za.y), O[dg][4 * k + 3] * rs * gg.w * bfhi(za.y));
                *(u32x2*)(P.Mb + R * D + h * 128 + dv0) = w;
            }
    }
}
__device__ __forceinline__ f32x4 unpk_lo(const u32x4 v) { return (f32x4){bflo(v.x), bfhi(v.x), bflo(v.y), bfhi(v.y)}; }
__device__ __forceinline__ f32x4 unpk_hi(const u32x4 v) { return (f32x4){bflo(v.z), bfhi(v.z), bflo(v.w), bfhi(v.w)}; }
__device__ __forceinline__ void conv_row(const Ptrs& P, int R, int lane) {
    const int c0 = lane * 8;
    f32x4 a0, a1, b0, b1, d0, d1;
    if (R < R_DEC) { const int b = R / SEQ, t = R % SEQ; const bf16* cp = P.CUb + ((size_t)b * KVP + NMETA + t) * 512 + c0;
        const u32x4 x0 = *(const u32x4*)(cp - 1024), x1 = *(const u32x4*)(cp - 512), x2 = *(const u32x4*)cp;
        a0 = unpk_lo(x0); a1 = unpk_hi(x0); b0 = unpk_lo(x1); b1 = unpk_hi(x1); d0 = unpk_lo(x2); d1 = unpk_hi(x2);
    } else { const int r = R - R_DEC, b = r / DS, t = r % DS; const bf16* cp = P.CUd + (size_t)r * 512 + c0;
        const u32x4 x2 = *(const u32x4*)cp; d0 = unpk_lo(x2); d1 = unpk_hi(x2);
        if (t >= 1) { const u32x4 x1 = *(const u32x4*)(cp - 512); b0 = unpk_lo(x1); b1 = unpk_hi(x1); }
        else { const float* sp = P.sc + ((size_t)b * 2 + 1) * 512 + c0; b0 = *(const f32x4*)sp; b1 = *(const f32x4*)(sp + 4); }
        if (t >= 2) { const u32x4 x0 = *(const u32x4*)(cp - 1024); a0 = unpk_lo(x0); a1 = unpk_hi(x0); }
        else { const float* sp = P.sc + ((size_t)b * 2 + t) * 512 + c0; a0 = *(const f32x4*)sp; a1 = *(const f32x4*)(sp + 4); }
    }
    const f32x4 w00 = *(const f32x4*)(P.cw + c0), w01 = *(const f32x4*)(P.cw + c0 + 4), w10 = *(const f32x4*)(P.cw + 512 + c0), w11 = *(const f32x4*)(P.cw + 512 + c0 + 4),
                w20 = *(const f32x4*)(P.cw + 1024 + c0), w21 = *(const f32x4*)(P.cw + 1024 + c0 + 4);
    const u32x4 gv = *(const u32x4*)(P.Gb + (size_t)R * 512 + c0);
    const f32x4 y0 = unpk_lo(gv) * (w00 * a0 + w10 * b0 + w20 * d0), y1 = unpk_hi(gv) * (w01 * a1 + w11 * b1 + w21 * d1);
    *(u32x4*)(P.Mb + (size_t)R * D + 512 + c0) = pack8(y0, y1);
}
__device__ __forceinline__ void p2_attention(const Ptrs& P, LAS unsigned char* lds, int blk, int G, int wave, int lane) {
    for (int i = threadIdx.x; i < NH * 256; i += NWAVES * 64) { const int h = i >> 8, rel = (i & 255) - 192;
        ((LAS float*)(lds + AT_LUT))[i] = (P.relb[rel_bucket(rel) * NH + h] - P.relb[15 * NH + h]) * LOG2E; }
    const float d1 = wave_sum(P.lq1[lane] * P.lk1[lane]), d2 = wave_sum(P.lq2[lane] * P.lk2[lane]);
    const float lam = expf(d1) - expf(d2) + LAM_INIT;
    __syncthreads();
#ifndef NO_CONV
    { const int gw = blk * NWAVES + wave, NGW = G * NWAVES; for (int R = gw; R < R_META; R += NGW) conv_row(P, R, lane); }
#endif
    const int npair = NB * NH * 16;
    const int ndec = (blk < DB * NH) ? (DB * NH - 1 - blk) / G + 1 : 0;
    const bool xmap = (G % 8 == 0) && (npair % G) == 0;
    const int npr = xmap ? (npair / G) : ((blk < npair) ? (npair - 1 - blk) / G + 1 : 0);
#pragma unroll 1
    for (int i = 0; i < ndec + 2 * npr; ++i) {
        if (i < ndec) { const int u = blk + i * G; attn_unit(true, P, lds, u >> 2, u & 3, 0, lam, wave, lane); }
        else { const int ii = (i - ndec) >> 1, second = (i - ndec) & 1;
            const int p = xmap ? (blk % 8) * (npair / 8) + blk / 8 + ii * (G / 8) : blk + ii * G;
            const int bh = p >> 4, j = p & 15;
            attn_unit(false, P, lds, bh >> 2, bh & 3, second ? j : 31 - j, lam, wave, lane); }
    }
}
__device__ __forceinline__ void p4_final_norm(const Ptrs& P, int blk, int G, int wave, int lane) {
    const int gw = blk * NWAVES + wave, NGW = G * NWAVES;
    for (int R = gw; R < R_META; R += NGW) {
        float ss; float* y;
        if (R < R_DEC) { ss = lane < 16 ? P.part[(size_t)R * 16 + lane] : 0.f; y = P.out + O_YP + (size_t)R * D; }
        else { ss = P.partD[(R - R_DEC) * 64 + lane]; y = P.out + O_YS + (size_t)(R - R_DEC) * D; }
        const float rstd = 1.0f / sqrtf(wave_sum(ss) * (1.f / D) + EPS);
        f32x4* yr = (f32x4*)y + lane; const f32x4* gr = (const f32x4*)P.fg + lane;
#pragma unroll
        for (int j = 0; j < 4; ++j) yr[64 * j] = yr[64 * j] * rstd * gr[64 * j];
    }
}

constexpr size_t WS_CTL = 0, CTL_ZERO_BYTES = 131072;
constexpr int LDSCTL_OFF = 139264;
#define XB_TMO      128
#define XB_XCNT(j)  (256  + 64 * (j))
#define XB_XSUB(j)  (1280 + 64 * (j))
#define XB_XGEN(j)  (2304 + 64 * (j))
#define XB_TOP      3328
#define XB_TOPGEN   3392
#define XCD_BAR_WORDS 3456
#define XB_SPIN_CAP (1u << 18)

__device__ __forceinline__ unsigned xb_ld(unsigned* p)              { return __hip_atomic_load(p, __ATOMIC_RELAXED, __HIP_MEMORY_SCOPE_AGENT); }
__device__ __forceinline__ unsigned xb_add(unsigned* p, unsigned v) { return __hip_atomic_fetch_add(p, v, __ATOMIC_RELAXED, __HIP_MEMORY_SCOPE_AGENT); }
__device__ __forceinline__ unsigned xb_xcc_id() { return (unsigned)__builtin_amdgcn_s_getreg((3 << 11) | 20) & 0xFu; }
#define XB_SPIN(cond, bar) do { unsigned _sp = 0; while (cond) { __builtin_amdgcn_s_sleep(1); \
    if ((++_sp & 255u) == 0u) { if (xb_ld(&(bar)[XB_TMO])) break; if (_sp > XB_SPIN_CAP) { atomicAdd(&(bar)[XB_TMO], 1u); break; } } } } while (0)

struct XcdBarrier {
    unsigned* bar; unsigned x;
    volatile LAS unsigned* st;
};

__device__ __forceinline__ XcdBarrier xcd_barrier_post(unsigned* bar, volatile LAS unsigned* st) {
    XcdBarrier b; b.bar = bar; b.x = xb_xcc_id(); b.st = st;
    if (threadIdx.x == 0) (void)xb_add(&bar[XB_XCNT(b.x)], 1u);
    return b;
}
__device__ __forceinline__ void xcd_barrier_complete(unsigned* bar, unsigned x, unsigned& nloc, unsigned& nx) {
    const unsigned G = gridDim.x * gridDim.y * gridDim.z;
    unsigned sum, cnt, mine, sp = 0u;
    for (;;) {
        sum = 0u; cnt = 0u; mine = 0u;
#pragma unroll
        for (unsigned j = 0; j < 16; ++j) { const unsigned c = xb_ld(&bar[XB_XCNT(j)]); sum += c; cnt += (c > 0u) ? 1u : 0u; mine = (j == x) ? c : mine; }
        if (sum == G) break;
        __builtin_amdgcn_s_sleep(1);
        if ((++sp & 255u) == 0u) { if (xb_ld(&bar[XB_TMO])) break; if (sp > XB_SPIN_CAP) { atomicAdd(&bar[XB_TMO], 1u); break; } }
    }
    nloc = mine > 0u ? mine : 1u; nx = cnt > 0u ? cnt : 1u;
}

__device__ __forceinline__ void xcd_barrier(const XcdBarrier& b) {
    asm volatile("s_waitcnt vmcnt(0)" ::: "memory");
    __syncthreads();
    if (threadIdx.x == 0) {
        unsigned* bar = b.bar;
        __builtin_amdgcn_s_waitcnt(0);
        unsigned nloc = b.st[0], nx = b.st[1];
        if (nloc == 0u) { xcd_barrier_complete(bar, b.x, nloc, nx); b.st[0] = nloc; b.st[1] = nx; }
        const unsigned old = xb_add(&bar[XB_XSUB(b.x)], 1u);
        const unsigned gen = old / nloc;
        if (old + 1u == (gen + 1u) * nloc) {
            __builtin_amdgcn_fence(__ATOMIC_RELEASE, "agent");
            asm volatile("s_waitcnt vmcnt(0)" ::: "memory");
            const unsigned og = xb_add(&bar[XB_TOP], 1u);
            const unsigned tg = og / nx;
            if (og + 1u == (tg + 1u) * nx) xb_add(&bar[XB_TOPGEN], 1u);
            else XB_SPIN(xb_ld(&bar[XB_TOPGEN]) == tg, bar);
            __builtin_amdgcn_fence(__ATOMIC_ACQUIRE, "agent");
            xb_add(&bar[XB_XGEN(b.x)], 1u);
            asm volatile("s_waitcnt vmcnt(0)" ::: "memory");
        } else {
            XB_SPIN(xb_ld(&bar[XB_XGEN(b.x)]) == gen, bar);
            __builtin_amdgcn_fence(__ATOMIC_ACQUIRE, "agent");
            asm volatile("s_waitcnt vmcnt(0)" ::: "memory");
        }
    }
    __syncthreads();
}


struct Args { const float* in[17]; float* out; unsigned char* ws; int ph_lo, ph_hi, li, pad; };
__global__ void __launch_bounds__(NWAVES * 64, 2) fwd_kernel(Args a) {
    extern __shared__ __attribute__((aligned(16))) unsigned char lds_raw[];
    LAS unsigned char* lds = (LAS unsigned char*)lds_raw;
    const int tid = threadIdx.x, lane = tid & 63, wave = __builtin_amdgcn_readfirstlane(tid >> 6);
    const int G = gridDim.x, blk = blockIdx.x;
    const int vcu = (G % 8 == 0) ? (blk % 8) * (G / 8) + blk / 8 : blk;
    Ptrs P;
    P.xp = a.in[0]; P.xs = a.in[1]; P.ck = a.in[2]; P.cv = a.in[3]; P.sc = a.in[4]; P.meta = a.in[5]; P.relb = a.in[6]; P.ng = a.in[7]; P.win = a.in[8]; P.cw = a.in[9];
    P.lq1 = a.in[10]; P.lk1 = a.in[11]; P.lq2 = a.in[12]; P.lk2 = a.in[13]; P.sg = a.in[14]; P.wout = a.in[15]; P.fg = a.in[16];
    P.out = a.out;
    unsigned char* ws = a.ws;
    P.WtIn = (bf16*)(ws + WS_WIN); P.WtOut = (bf16*)(ws + WS_WOUT); P.XN = (bf16*)(ws + WS_XN); P.Qb = (bf16*)(ws + WS_Q); P.ZA = (bf16*)(ws + WS_ZA); P.Gb = (bf16*)(ws + WS_G);
    P.Kb = (bf16*)(ws + WS_K); P.Vb = (bf16*)(ws + WS_V); P.CUb = (bf16*)(ws + WS_CU); P.KbD = (bf16*)(ws + WS_KD); P.VbD = (bf16*)(ws + WS_VD); P.CUd = (bf16*)(ws + WS_CUD); P.Mb = (bf16*)(ws + WS_M);
    P.part = (float*)(ws + WS_PART); P.partD = (float*)(ws + WS_PARTD);
    const int lo = a.ph_lo, hi = a.ph_hi;
    for (int u = tid; u < (LDS_BYTES - LDSCTL_OFF) / 4; u += NWAVES * 64) ((LAS unsigned*)(lds + LDSCTL_OFF))[u] = 0u;
    __syncthreads();
    XcdBarrier bar = xcd_barrier_post((unsigned*)(ws + WS_CTL) + a.li * XCD_BAR_WORDS, (volatile LAS unsigned*)(lds + LDSCTL_OFF) + 8);
#ifndef PHASE_MASK
#define PHASE_MASK 31
#endif
#define IN(k) (((PHASE_MASK >> (k)) & 1) && lo <= (k) && (k) < hi)
#define SEAM(k) do { if (IN(k) && IN((k) + 1)) { xcd_barrier(bar); } } while (0)
    if (IN(0)) { p0_prologue(P, lds, vcu, G, wave, lane); }
    SEAM(0);
    if (IN(1)) {
        pg8::Gemm g{P.XN, P.WtIn, MFR, WIN, D}; pg8::StaticOrder S; S.init(MFR, WIN, G, blk);
        EpiIn E{P.Qb, P.ZA, P.Gb, P.Kb, P.Vb, P.CUb, P.out};
#ifndef NO_BIG
        pg8::gemm_phase<EpiIn, pg8::StaticOrder, true, true>(lds, g, S, E);
#endif
#ifndef NO_SMALL
        for (int j = blk; j < 256; j += G) small_in_tile(P, lds, j, wave, lane);
#endif
    }
    SEAM(1);
    if (IN(2)) { p2_attention(P, lds, blk, G, wave, lane); }
    SEAM(2);
    if (IN(3)) {
        pg8::Gemm g{P.Mb, P.WtOut, MFR, D, D}; pg8::StaticOrder S; S.init(MFR, D, G, blk);
        EpiOut E{P.xp, P.out + O_YP, P.part};
        pg8::gemm_phase<EpiOut, pg8::StaticOrder, true, true>(lds, g, S, E);
        for (int j = blk; j < 256; j += G) small_out_tile(P, lds, j, wave, lane);
    }
    SEAM(3);
    if (IN(4)) { p4_final_norm(P, blk, G, wave, lane); }
#undef IN
#undef SEAM
}

extern "C" void kernel_launch(void* const* d_in, const int* in_sizes, int n_in, void* d_out, int out_size, void* d_ws, size_t ws_size, hipStream_t stream) {
    static int grid = 0;
    if (grid == 0) {
        if (n_in != 17 || (size_t)out_size != O_END || ws_size < WS_END) { fprintf(stderr, "kernel_launch: unexpected shapes (n_in %d out %d ws %zu)\n", n_in, out_size, ws_size); grid = -1; return; }
        int dev = 0, cus = 0, per_cu = 0;
        if (hipGetDevice(&dev) != hipSuccess || hipDeviceGetAttribute(&cus, hipDeviceAttributeMultiprocessorCount, dev) != hipSuccess) { grid = -1; return; }
        if (hipFuncSetAttribute((const void*)fwd_kernel, hipFuncAttributeMaxDynamicSharedMemorySize, LDS_BYTES) != hipSuccess) { fprintf(stderr, "kernel_launch: hipFuncSetAttribute failed\n"); grid = -1; return; }
        if (hipOccupancyMaxActiveBlocksPerMultiprocessor(&per_cu, (const void*)fwd_kernel, NWAVES * 64, LDS_BYTES) != hipSuccess || per_cu < 1) { fprintf(stderr, "kernel_launch: occupancy query says %d\n", per_cu); per_cu = 1; }
        (void)hipGetLastError();
        grid = cus;
        fprintf(stderr, "kernel_launch: cus %d per_cu %d grid %d\n", cus, per_cu, grid);
    }
    if (grid < 0) return;
    Args a{};
    for (int i = 0; i < 17; ++i) a.in[i] = (const float*)d_in[i];
    a.out = (float*)d_out; a.ws = (unsigned char*)d_ws;
    if (hipMemsetAsync((char*)d_ws + WS_CTL, 0, CTL_ZERO_BYTES, stream) != hipSuccess) { fprintf(stderr, "kernel_launch: memset failed\n"); return; }
#if defined(REPEAT_PHASE)
    const int k = REPEAT_PHASE; const int nl = 3; const int lo3[3] = {0, k, k + 1}, hi3[3] = {k + 1, k + 1, 5};
#elif N_LAUNCHES == 1
    const int nl = 1; const int lo3[1] = {0}, hi3[1] = {5};
#else
    const int nl = 5; const int lo3[5] = {0, 1, 2, 3, 4}, hi3[5] = {1, 2, 3, 4, 5};
#endif
    for (int i = 0; i < nl; ++i) { a.ph_lo = lo3[i]; a.ph_hi = hi3[i]; a.li = i;
        hipLaunchKernelGGL(fwd_kernel, dim3(grid), dim3(NWAVES * 64), LDS_BYTES, stream, a);
        const hipError_t le = hipPeekAtLastError();
        if (le != hipSuccess) { fprintf(stderr, "kernel_launch: launch %d failed: %s (grid %d)\n", i, hipGetErrorName(le), grid); break; } }
}
```
